# Optimizing an MI355X kernel written in HIP

```python
import jax, jax.numpy as jnp
from jax import lax
import numpy as np

D_MODEL = 2048
BATCH = 2
SEQ = 8192
DEPTH = 2

GRID_W = 64
CTX_LEN = 256
RMS_EPS = 1e-6
ROPE_BASE = 10000.0
N_BRANCH = 3
A_WIDTH = 512
CONV_K = 3
GLA_HEADS = 6
GLA_DK = 64
GLA_DV = 128
GLA_KD = GLA_HEADS * GLA_DK
GLA_VD = GLA_HEADS * GLA_DV
GLA_LOWRANK = 16
GLA_TAU = 16.0
GLA_CHUNK = 64
NA_HEADS = 6
NA_DH = 128
NA_D = NA_HEADS * NA_DH
NA_WIN_H = 8
NA_WIN_W = 16
FFN_HIDDEN = -(-8 * D_MODEL // (3 * 256)) * 256
SPLIT_SIZES = (A_WIDTH, A_WIDTH, A_WIDTH,
               GLA_KD, GLA_KD, GLA_VD, GLA_VD, GLA_LOWRANK, GLA_LOWRANK,
               NA_D, NA_D, NA_D,
               N_BRANCH * D_MODEL)
IN_COLS = sum(SPLIT_SIZES)

kernel_name = "hybrid_conv_gla_natten_dit_block"


def rmsnorm(x, g):
    xf = x.astype(jnp.float32)
    y = xf * lax.rsqrt(jnp.mean(xf * xf, axis=-1, keepdims=True) + RMS_EPS)
    return (y * g.astype(jnp.float32)).astype(x.dtype)


def adaln(cvec, w, b):
    m = jax.nn.silu(cvec) @ w + b
    return [t[:, None, :] for t in jnp.split(m, 6, axis=-1)]


def split_columns(p):
    idx = np.cumsum(np.array(SPLIT_SIZES))[:-1].tolist()
    return jnp.split(p, idx, axis=-1)


def heads(t, h):
    return t.reshape(t.shape[0], t.shape[1], h, -1)


def axial_rope(T, dim, dtype):
    pos = jnp.arange(T, dtype=jnp.int32)
    row = (pos // GRID_W).astype(jnp.float32)
    col = (pos % GRID_W).astype(jnp.float32)
    per_axis = dim // 2
    inv = ROPE_BASE ** (-jnp.arange(0, per_axis, 2, dtype=jnp.float32) / per_axis)
    ang = jnp.concatenate([row[:, None] * inv, col[:, None] * inv], axis=-1)
    return jnp.cos(ang).astype(dtype), jnp.sin(ang).astype(dtype)


def apply_rope(x, cos, sin):
    half = x.shape[-1] // 2
    x1, x2 = x[..., :half], x[..., half:]
    cos, sin = cos[None, :, None, :], sin[None, :, None, :]
    return jnp.concatenate([x1 * cos - x2 * sin, x1 * sin + x2 * cos], axis=-1)


def gated_short_conv(a_in, a_b, a_c, w):
    u = a_c * a_in
    up = jnp.pad(u, ((0, 0), (1, 1), (0, 0)))
    conv = w[0] * up[:, :-2] + w[1] * up[:, 1:-1] + w[2] * up[:, 2:]
    return a_b * conv


def gla_chunked(q, k, v, log_a, s0):
    B, T, H, DK = q.shape
    C = GLA_CHUNK
    n = T // C

    def to_chunks(t):
        return t.reshape(B, n, C, H, -1).transpose(1, 0, 3, 2, 4)

    xs = tuple(to_chunks(t) for t in (q, k, v, log_a))
    mask = jnp.tril(jnp.ones((C, C), dtype=bool))[:, :, None]

    def step(s, inp):
        qi, ki, vi, gi = (t.astype(jnp.float32) for t in inp)
        b = jnp.cumsum(gi, axis=2)
        diff = b[:, :, :, None, :] - b[:, :, None, :, :]
        decay = jnp.exp(jnp.where(mask, diff, -jnp.inf))
        attn = jnp.einsum('bhtd,bhsd,bhtsd->bhts', qi, ki, decay)
        o = jnp.einsum('bhts,bhsv->bhtv', attn, vi) + jnp.einsum('bhtd,bhdv->bhtv', qi * jnp.exp(b), s)
        b_last = b[:, :, -1:, :]
        s_new = jnp.exp(b_last[:, :, 0, :, None]) * s + jnp.einsum('bhsd,bhsv->bhdv', ki * jnp.exp(b_last - b), vi)
        return s_new, o

    s_fin, o = lax.scan(step, s0, xs)
    o = o.transpose(1, 0, 3, 2, 4).reshape(B, T, H, -1).astype(v.dtype)
    return o, s_fin


def gla_bidir(q, k, v, la_f, la_b, s_f0, s_b0):
    o_f, s_f = gla_chunked(q, k, v, la_f, s_f0)
    flip = lambda t: jnp.flip(t, axis=1)
    o_b, s_b = gla_chunked(flip(q), flip(k), flip(v), flip(la_b), s_b0)
    return o_f + flip(o_b), s_f, s_b


def gla_inputs(g_q, g_k, g_v, g_af, g_ab, wa_f, ba_f, wa_b, ba_b, rope):
    B, T, _ = g_q.shape
    q = heads(g_q, GLA_HEADS) * (GLA_DK ** -0.5)
    k = heads(g_k, GLA_HEADS)
    v = heads(g_v, GLA_HEADS)
    if rope is not None:
        q = apply_rope(q, *rope)
        k = apply_rope(k, *rope)
    la_f = jax.nn.log_sigmoid((g_af @ wa_f + ba_f).astype(jnp.float32)) / GLA_TAU
    la_b = jax.nn.log_sigmoid((g_ab @ wa_b + ba_b).astype(jnp.float32)) / GLA_TAU
    return q, k, v, la_f.reshape(B, T, GLA_HEADS, GLA_DK), la_b.reshape(B, T, GLA_HEADS, GLA_DK)


def gla_output(o, g_r, g_norm):
    B, T = o.shape[:2]
    return rmsnorm(o, g_norm).reshape(B, T, GLA_VD) * jax.nn.silu(g_r)


def neighbourhood_attention(q, k, v, k_ctx, v_ctx, rpb):
    B, S, H, dh = q.shape
    rows = S // GRID_W
    kh = min(NA_WIN_H, rows)
    kw = NA_WIN_W
    qg = q.reshape(B, rows, GRID_W, H, dh)
    kg = k.reshape(B, rows, GRID_W, H, dh)
    vg = v.reshape(B, rows, GRID_W, H, dh)
    col = np.arange(GRID_W)
    col_start = np.clip(col - kw // 2, 0, GRID_W - kw)
    col_idx = col_start[:, None] + np.arange(kw)[None, :]
    col_off = col_idx - col[:, None] + (NA_WIN_W - 1)
    n_loc = kh * kw

    def row_block(r):
        r_start = jnp.clip(r - kh // 2, 0, rows - kh)
        q_r = lax.dynamic_index_in_dim(qg, r, axis=1, keepdims=False)
        k_rows = lax.dynamic_slice_in_dim(kg, r_start, kh, axis=1)
        v_rows = lax.dynamic_slice_in_dim(vg, r_start, kh, axis=1)
        k_win = k_rows[:, :, col_idx]
        v_win = v_rows[:, :, col_idx]
        s_loc = jnp.einsum('bqhd,biqjhd->bhqij', q_r, k_win).astype(jnp.float32)
        row_off = r_start + jnp.arange(kh) - r + (NA_WIN_H - 1)
        bias = rpb[:, row_off][:, :, col_off]
        s_loc = s_loc + bias.transpose(0, 2, 1, 3)[None].astype(jnp.float32)
        s_ctx = jnp.einsum('bqhd,bchd->bhqc', q_r, k_ctx).astype(jnp.float32)
        scores = jnp.concatenate([s_loc.reshape(B, H, GRID_W, n_loc), s_ctx], axis=-1)
        p = jax.nn.softmax(scores, axis=-1).astype(v.dtype)
        p_loc = p[..., :n_loc].reshape(B, H, GRID_W, kh, kw)
        p_ctx = p[..., n_loc:]
        return (jnp.einsum('bhqij,biqjhd->bqhd', p_loc, v_win)
                + jnp.einsum('bhqc,bchd->bqhd', p_ctx, v_ctx))

    o = lax.map(row_block, jnp.arange(rows))
    return o.transpose(1, 0, 2, 3, 4).reshape(B, S, H * dh)


def context_attention(q, k, v):
    B, T, H, dh = q.shape
    s = jnp.einsum('bqhd,bkhd->bhqk', q, k).astype(jnp.float32)
    p = jax.nn.softmax(s, axis=-1).astype(v.dtype)
    return jnp.einsum('bhqk,bkhd->bqhd', p, v).reshape(B, T, H * dh)


def merge_branches(a, g, n, gates, w_a_out, w_g_out, w_n_out, w_o):
    ga, gg, gn = jnp.split(jax.nn.sigmoid(gates), N_BRANCH, axis=-1)
    y = ga * (a @ w_a_out) + gg * (g @ w_g_out) + gn * (n @ w_n_out)
    return y @ w_o


def token_mixers(n, nc, w_in, conv_w, wa_f, ba_f, wa_b, ba_b, g_gla, rpb,
                 w_a_out, w_g_out, w_n_out, w_o, rope, need_ctx):
    B = n.shape[0]
    pl = split_columns(n @ w_in)
    pc = split_columns(nc @ w_in)
    qc_, kc_, vc_, lfc, lbc = gla_inputs(pc[3], pc[4], pc[5], pc[7], pc[8], wa_f, ba_f, wa_b, ba_b, None)
    s0 = jnp.zeros((B, GLA_HEADS, GLA_DK, GLA_DV), jnp.float32)
    o_gc, s_f, s_b = gla_bidir(qc_, kc_, vc_, lfc, lbc, s0, s0)
    q_, k_, v_, lf, lb = gla_inputs(pl[3], pl[4], pl[5], pl[7], pl[8], wa_f, ba_f, wa_b, ba_b, rope)
    o_g, _, _ = gla_bidir(q_, k_, v_, lf, lb, s_f, s_b)
    g_lat = gla_output(o_g, pl[6], g_gla)
    scale = NA_DH ** -0.5
    k_ctx = heads(pc[10], NA_HEADS)
    v_ctx = heads(pc[11], NA_HEADS)
    na_lat = neighbourhood_attention(heads(pl[9], NA_HEADS) * scale, heads(pl[10], NA_HEADS),
                                     heads(pl[11], NA_HEADS), k_ctx, v_ctx, rpb)
    a_lat = gated_short_conv(pl[0], pl[1], pl[2], conv_w)
    y = merge_branches(a_lat, g_lat, na_lat, pl[12], w_a_out, w_g_out, w_n_out, w_o)
    if not need_ctx:
        return y, None
    a_ctx = gated_short_conv(pc[0], pc[1], pc[2], conv_w)
    g_ctx = gla_output(o_gc, pc[6], g_gla)
    na_ctx = context_attention(heads(pc[9], NA_HEADS) * scale, k_ctx, v_ctx)
    yc = merge_branches(a_ctx, g_ctx, na_ctx, pc[12], w_a_out, w_g_out, w_n_out, w_o)
    return y, yc


def swiglu(n, w1, w3, w2):
    return (jax.nn.silu(n @ w1) * (n @ w3)) @ w2


def setup_inputs(seed: int = 0) -> dict:
    key = jax.random.key(seed)
    ks = jax.random.split(key, 25)

    def nrm(k, shape, scale):
        return jax.random.normal(k, shape, jnp.float32) * scale

    D = D_MODEL
    return {
        "x": nrm(ks[0], (BATCH, SEQ, D), 1.0),
        "c": nrm(ks[1], (BATCH, D), 1.0),
        "ctx": nrm(ks[2], (BATCH, CTX_LEN, D), 1.0),
        "c_ctx": nrm(ks[3], (D,), 1.0),
        "w_ada": nrm(ks[4], (DEPTH, D, 6 * D), 0.5 * D ** -0.5),
        "b_ada": nrm(ks[5], (DEPTH, 6 * D), 0.02),
        "g_mix": 1.0 + nrm(ks[6], (DEPTH, D), 0.05),
        "g_ffn": 1.0 + nrm(ks[7], (DEPTH, D), 0.05),
        "w_in": nrm(ks[8], (DEPTH, D, IN_COLS), D ** -0.5),
        "conv_w": nrm(ks[9], (DEPTH, CONV_K, A_WIDTH), CONV_K ** -0.5),
        "gla_wa_f": nrm(ks[10], (DEPTH, GLA_LOWRANK, GLA_KD), GLA_LOWRANK ** -0.5),
        "gla_ba_f": nrm(ks[11], (DEPTH, GLA_KD), 0.1),
        "gla_wa_b": nrm(ks[12], (DEPTH, GLA_LOWRANK, GLA_KD), GLA_LOWRANK ** -0.5),
        "gla_ba_b": nrm(ks[13], (DEPTH, GLA_KD), 0.1),
        "gla_g_norm": 1.0 + nrm(ks[14], (DEPTH, GLA_DV), 0.05),
        "na_rpb": nrm(ks[15], (DEPTH, NA_HEADS, 2 * NA_WIN_H - 1, 2 * NA_WIN_W - 1), 0.1),
        "w_a_out": nrm(ks[16], (DEPTH, A_WIDTH, D), A_WIDTH ** -0.5),
        "w_g_out": nrm(ks[17], (DEPTH, GLA_VD, D), GLA_VD ** -0.5),
        "w_n_out": nrm(ks[18], (DEPTH, NA_D, D), NA_D ** -0.5),
        "w_o": nrm(ks[19], (DEPTH, D, D), D ** -0.5),
        "w_ffn1": nrm(ks[20], (DEPTH, D, FFN_HIDDEN), D ** -0.5),
        "w_ffn3": nrm(ks[21], (DEPTH, D, FFN_HIDDEN), D ** -0.5),
        "w_ffn2": nrm(ks[22], (DEPTH, FFN_HIDDEN, D), FFN_HIDDEN ** -0.5),
        "g_final": 1.0 + nrm(ks[23], (D,), 0.05),
    }


def reference(x, c, ctx, c_ctx, w_ada, b_ada, g_mix, g_ffn, w_in, conv_w,
              gla_wa_f, gla_ba_f, gla_wa_b, gla_ba_b, gla_g_norm, na_rpb,
              w_a_out, w_g_out, w_n_out, w_o, w_ffn1, w_ffn3, w_ffn2, g_final):
    S = x.shape[1]
    rope = axial_rope(S, GLA_DK, x.dtype)
    h, hc = x, ctx
    for l in range(DEPTH):
        need_ctx = l < DEPTH - 1
        sm, scm, gm, sf, scf, gf = adaln(c, w_ada[l], b_ada[l])
        sm_c, scm_c, gm_c, sf_c, scf_c, gf_c = adaln(c_ctx[None, :], w_ada[l], b_ada[l])
        n = rmsnorm(h, g_mix[l]) * (1 + scm) + sm
        nc = rmsnorm(hc, g_mix[l]) * (1 + scm_c) + sm_c
        y, yc = token_mixers(n, nc, w_in[l], conv_w[l], gla_wa_f[l], gla_ba_f[l], gla_wa_b[l], gla_ba_b[l],
                             gla_g_norm[l], na_rpb[l], w_a_out[l], w_g_out[l], w_n_out[l], w_o[l],
                             rope, need_ctx)
        h = h + gm * y
        n = rmsnorm(h, g_ffn[l]) * (1 + scf) + sf
        h = h + gf * swiglu(n, w_ffn1[l], w_ffn3[l], w_ffn2[l])
        if need_ctx:
            hc = hc + gm_c * yc
            nc = rmsnorm(hc, g_ffn[l]) * (1 + scf_c) + sf_c
            hc = hc + gf_c * swiglu(nc, w_ffn1[l], w_ffn3[l], w_ffn2[l])
    return rmsnorm(h, g_final)
```

```cpp
#include <hip/hip_runtime.h>
#include <hip/hip_cooperative_groups.h>
#include <cstdio>
#include <cstdint>
namespace cg = cooperative_groups;
namespace pg8 {
#define PG8_LAS __attribute__((address_space(3)))
typedef unsigned short bf16_t;
typedef short bf16x8 __attribute__((ext_vector_type(8)));
typedef float f32x4 __attribute__((ext_vector_type(4)));
typedef unsigned u32x4 __attribute__((ext_vector_type(4)));
constexpr int BM = 256, BK = 64, HALF = 128, HTB = HALF * BK * 2  , STAGE_BYTES = 8 * HTB, NXCD = 8, WGM = 4;

__host__ __device__ __forceinline__ int lds_byte(int r, int c) { const int st = (r >> 4) * 2 + (c >> 5), rr = r & 15, cc = c & 31, ob = rr * 64 + cc * 2; return st * 1024 + (ob ^ (((ob >> 9) & 1) << 5)); }
__host__ __device__ __forceinline__ void stage_rc(int b, int& R, int& C) { const int st = b / 1024, sb = b % 1024, swz = sb ^ (((sb >> 9) & 1) << 5); R = (st >> 1) * 16 + swz / 64; C = (st & 1) * 32 + (swz % 64) / 2; }
__host__ __device__ __forceinline__ int perm32(int rho) { const int n = rho >> 4, i = rho & 15; return 8 * (i >> 2) + 4 * n + (i & 3); }

struct Unit { int pm, pn, ko; };
struct Gemm { const bf16_t* A; const bf16_t* Bt; int M, N, K, kloop; };

struct StaticOrder {
    int nM, nN, nwg, G, c;
    __host__ __device__ void init(int M, int N, int G_, int c_) { nM = M / BM; nN = N / BM; nwg = nM * nN; G = G_; c = c_; }
    __host__ __device__ bool next(int i, Unit& u) const {
        const long L = (long)i * G + c; if (L >= nwg) return false;
        int wgid = (int)L; { const int q = nwg / NXCD, r = nwg % NXCD, xcd = wgid % NXCD, off = wgid / NXCD; wgid = (xcd < r ? xcd * (q + 1) : r * (q + 1) + (xcd - r) * q) + off; }
        const int nig = WGM * nN, gid = wgid / nig, fm = gid * WGM, gsz = (nM - fm) < WGM ? (nM - fm) : WGM;
        u.pm = fm + ((wgid % nig) % gsz); u.pn = (wgid % nig) / gsz; u.ko = 0; return true;
    }
    __device__ __forceinline__ void a_ready(const Unit&) const {}
    __device__ __forceinline__ void done(const Unit&) const {}
};
template <int NSPLIT, int KLOOP> struct SplitKOrder {
    int G, c;
    __host__ __device__ void init(int G_, int c_) { G = G_; c = c_; }
    __host__ __device__ bool next(int i, Unit& u) const { const int L = i * G + c; if (L >= 16 * NSPLIT) return false; const int t = L / NSPLIT; u.ko = (L % NSPLIT) * KLOOP; u.pm = t >> 3; u.pn = t & 7; return true; }
    __device__ __forceinline__ void a_ready(const Unit&) const {}
    __device__ __forceinline__ void done(const Unit&) const {}
};
struct LatentOrder {
    StaticOrder so; int c; bool panel;
    __host__ __device__ void init(int G_, int c_) { so.init(16384, 2048, G_, c_); c = c_; panel = (G_ == 256); }
    __host__ __device__ bool next(int i, Unit& u) const {
        if (!panel) return so.next(i, u);
        if (i >= 2) return false; const int x = c & 7, sl = c >> 3; u.pm = i * 32 + x * 4 + (sl >> 3); u.pn = sl & 7; u.ko = 0; return true; }
    __device__ __forceinline__ void a_ready(const Unit&) const {}
    __device__ __forceinline__ void done(const Unit&) const {}
};
__device__ __forceinline__ unsigned cvt_pk_bf16(float lo, float hi) { unsigned r; asm volatile("v_cvt_pk_bf16_f32 %0, %1, %2" : "=v"(r) : "v"(lo), "v"(hi)); return r; }
template <class Epi, class Sched, bool ALIGN_EPI = false, bool SP2 = false>
__device__ __forceinline__ void gemm_phase(PG8_LAS unsigned char* lds, const Gemm g, const Sched& S, const Epi& E) {
    int tid_ = threadIdx.x; asm volatile("" : "+v"(tid_)); const int tid = tid_, wid = __builtin_amdgcn_readfirstlane(tid >> 6), lane = tid & 63, wr = wid >> 2, wc = wid & 3, fr = lane & 15, fq = lane >> 4;
    const int K = g.K; int nt_ = (g.kloop ? g.kloop : K) / BK; asm volatile("" : "+s"(nt_)); const int nt = nt_;
    unsigned voffA[2], voffB[2];
#pragma unroll
    for (int i = 0; i < 2; ++i) { int R, C; stage_rc(tid * 16 + i * 8192, R, C); const int Rb = Epi::PERM ? ((R & ~31) + perm32(R & 31)) : R;
        voffA[i] = (unsigned)(R * K + C) * 2u; voffB[i] = (unsigned)(Rb * K + C) * 2u; }
    const size_t kstep = (size_t)(BK * 2);
    const size_t hstep = (size_t)HALF * K * 2;
    const size_t tstep = 2 * hstep;
    const unsigned ldsw = (unsigned)wid * 1024u;
    const int aoff = lds_byte(wr * 64 + fr, fq * 8), boff = lds_byte(wc * 32 + fr, fq * 8);
#define PG8_SA(b, h) (((b) * 2 + (h)) * HTB)
#define PG8_SB(b, h) ((4 + (b) * 2 + (h)) * HTB)
#define PG8_STAGE(bufoff, gbase, voff) do { _Pragma("unroll") for (int _i = 0; _i < 2; ++_i) \
        __builtin_amdgcn_global_load_lds((const unsigned*)((const char*)(gbase) + (voff)[_i]), (PG8_LAS unsigned*)(lds + (bufoff) + ldsw + _i * 8192), 16, 0, 0); } while (0)
#define PG8_LDA(dst, b, h) do { _Pragma("unroll") for (int m = 0; m < 4; ++m) _Pragma("unroll") for (int k = 0; k < 2; ++k) dst[m][k] = *(const PG8_LAS bf16x8*)(lds + PG8_SA(b, h) + aoff + m * 2048 + k * 1024); } while (0)
#define PG8_LDB(dst, b, h) do { _Pragma("unroll") for (int n = 0; n < 2; ++n) _Pragma("unroll") for (int k = 0; k < 2; ++k) dst[n][k] = *(const PG8_LAS bf16x8*)(lds + PG8_SB(b, h) + boff + n * 2048 + k * 1024); } while (0)
#define PG8_MMA(ai, bj, At, Bt) do { __builtin_amdgcn_s_setprio(1); _Pragma("unroll") for (int m = 0; m < 4; ++m) _Pragma("unroll") for (int n = 0; n < 2; ++n) _Pragma("unroll") for (int k = 0; k < 2; ++k) \
        acc[ai][bj][m][n] = __builtin_amdgcn_mfma_f32_16x16x32_bf16(Bt[n][k], At[m][k], acc[ai][bj][m][n], 0, 0, 0); __builtin_amdgcn_s_setprio(0); } while (0)
#define PG8_WAIT_V(n) asm volatile("s_waitcnt vmcnt(" #n ")" ::: "memory")
#define PG8_WAIT_L(n) asm volatile("s_waitcnt lgkmcnt(" #n ")" ::: "memory")
#define PG8_BAR __builtin_amdgcn_s_barrier()
#define PG8_SCHED __builtin_amdgcn_sched_barrier(0)
    Unit cur, nxt; int ui = 0;
    if (!S.next(0, cur)) return;
    f32x4 acc[2][2][4][2];
#pragma unroll
    for (int a = 0; a < 2; ++a)
#pragma unroll
        for (int b = 0; b < 2; ++b)
#pragma unroll
            for (int m = 0; m < 4; ++m)
#pragma unroll
                for (int n = 0; n < 2; ++n) acc[a][b][m][n] = (f32x4){0.f, 0.f, 0.f, 0.f};
    bf16x8 At[4][2], B0[2][2], B1[2][2];
    const char* cA = (const char*)g.A + (size_t)cur.pm * tstep + (size_t)cur.ko * 2; const char* cB = (const char*)g.Bt + (size_t)cur.pn * tstep + (size_t)cur.ko * 2;
    S.a_ready(cur);
    if constexpr (SP2) {
        PG8_STAGE(PG8_SB(0, 0), cB, voffB); PG8_STAGE(PG8_SB(0, 1), cB + hstep, voffB); PG8_STAGE(PG8_SA(0, 0), cA, voffA); PG8_STAGE(PG8_SA(0, 1), cA + hstep, voffA);
        if (wr == 1) PG8_BAR;
        PG8_WAIT_V(2); PG8_BAR;
        PG8_STAGE(PG8_SB(1, 0), cB + kstep, voffB); PG8_STAGE(PG8_SA(1, 0), cA + kstep, voffA); PG8_STAGE(PG8_SB(1, 1), cB + hstep + kstep, voffB);
        PG8_WAIT_V(6); PG8_BAR;
    } else {
        PG8_STAGE(PG8_SB(0, 0), cB, voffB); PG8_STAGE(PG8_SA(0, 0), cA, voffA); PG8_STAGE(PG8_SB(0, 1), cB + hstep, voffB); PG8_STAGE(PG8_SA(0, 1), cA + hstep, voffA);
        if (wr == 1) PG8_BAR;
        PG8_WAIT_V(4); PG8_BAR;
        PG8_STAGE(PG8_SB(1, 0), cB + kstep, voffB); PG8_STAGE(PG8_SA(1, 0), cA + kstep, voffA); PG8_STAGE(PG8_SB(1, 1), cB + hstep + kstep, voffB);
        PG8_WAIT_V(6); PG8_BAR;
    }
    for (;;) {
        const bool has_next = S.next(ui + 1, nxt);
        const char* nA = has_next ? (const char*)g.A + (size_t)nxt.pm * tstep + (size_t)nxt.ko * 2 : cA; const char* nB = has_next ? (const char*)g.Bt + (size_t)nxt.pn * tstep + (size_t)nxt.ko * 2 : cB;
        for (int t = 0; t < nt; t += 2) {
            if constexpr (Epi::MIDHOOK) { if (t == 8 || t == 20) E.mid(acc, cur, wr, wc, fr, fq, t); }
            const bool last = (t == nt - 2);
            const char* a1 = cA + (size_t)(t + 1) * kstep;
            const char* a2 = last ? nA : cA + (size_t)(t + 2) * kstep; const char* b2 = last ? nB : cB + (size_t)(t + 2) * kstep;
            const char* a3 = a2 + kstep; const char* b3 = b2 + kstep;
            if (last && has_next) S.a_ready(nxt);
            if constexpr (SP2) {
            PG8_LDB(B0, 0, 0); PG8_LDB(B1, 0, 1); PG8_SCHED; PG8_LDA(At, 0, 0); PG8_STAGE(PG8_SA(1, 1), a1 + hstep, voffA);
            PG8_WAIT_V(8); PG8_WAIT_L(0); PG8_BAR; PG8_MMA(0, 0, At, B0); PG8_MMA(0, 1, At, B1); PG8_BAR; PG8_SCHED;
            PG8_LDA(At, 0, 1); PG8_STAGE(PG8_SB(0, 0), b2, voffB); PG8_STAGE(PG8_SB(0, 1), b2 + hstep, voffB); PG8_STAGE(PG8_SA(0, 0), a2, voffA);
            PG8_WAIT_V(8); PG8_WAIT_L(0); PG8_BAR; PG8_MMA(1, 0, At, B0); PG8_MMA(1, 1, At, B1); PG8_BAR; PG8_SCHED;
            PG8_LDB(B0, 1, 0); PG8_LDB(B1, 1, 1); PG8_SCHED; PG8_LDA(At, 1, 0); PG8_STAGE(PG8_SA(0, 1), a2 + hstep, voffA);
            PG8_WAIT_V(8); PG8_WAIT_L(0); PG8_BAR; PG8_MMA(0, 0, At, B0); PG8_MMA(0, 1, At, B1); PG8_BAR; PG8_SCHED;
            PG8_LDA(At, 1, 1); PG8_STAGE(PG8_SB(1, 0), b3, voffB); PG8_STAGE(PG8_SB(1, 1), b3 + hstep, voffB); PG8_STAGE(PG8_SA(1, 0), a3, voffA);
            PG8_WAIT_V(8); PG8_WAIT_L(0); PG8_BAR; PG8_MMA(1, 0, At, B0); PG8_MMA(1, 1, At, B1); PG8_BAR; PG8_SCHED;
            } else {
            PG8_LDB(B0, 0, 0); PG8_SCHED; PG8_LDA(At, 0, 0); PG8_STAGE(PG8_SA(1, 1), a1 + hstep, voffA);
            PG8_WAIT_L(8); PG8_BAR; PG8_WAIT_L(0); PG8_MMA(0, 0, At, B0); PG8_BAR; PG8_SCHED;
            PG8_LDB(B1, 0, 1); PG8_STAGE(PG8_SB(0, 0), b2, voffB);
            PG8_BAR; PG8_WAIT_L(0); PG8_MMA(0, 1, At, B1); PG8_BAR;
            PG8_LDA(At, 0, 1); PG8_STAGE(PG8_SA(0, 0), a2, voffA);
            PG8_BAR; PG8_WAIT_L(0); PG8_MMA(1, 0, At, B0); PG8_BAR; PG8_SCHED;
            PG8_STAGE(PG8_SB(0, 1), b2 + hstep, voffB);
            PG8_WAIT_V(6); PG8_BAR; PG8_MMA(1, 1, At, B1); PG8_BAR;
            PG8_LDB(B0, 1, 0); PG8_SCHED; PG8_LDA(At, 1, 0); PG8_STAGE(PG8_SA(0, 1), a2 + hstep, voffA);
            PG8_WAIT_L(8); PG8_BAR; PG8_WAIT_L(0); PG8_MMA(0, 0, At, B0); PG8_BAR; PG8_SCHED;
            PG8_LDB(B1, 1, 1); PG8_STAGE(PG8_SB(1, 0), b3, voffB);
            PG8_BAR; PG8_WAIT_L(0); PG8_MMA(0, 1, At, B1); PG8_BAR;
            PG8_LDA(At, 1, 1); PG8_STAGE(PG8_SA(1, 0), a3, voffA);
            PG8_BAR; PG8_WAIT_L(0); PG8_MMA(1, 0, At, B0); PG8_BAR; PG8_SCHED;
            PG8_STAGE(PG8_SB(1, 1), b3 + hstep, voffB);
            PG8_WAIT_V(6); PG8_BAR; PG8_MMA(1, 1, At, B1); PG8_BAR;
            }
        }
        if constexpr (ALIGN_EPI) { if (wr == 0) PG8_BAR; }
        if constexpr (!Epi::AFTER_DRAIN) { E(acc, cur, wr, wc, fr, fq); S.done(cur); }
        if (!has_next) break;
#pragma unroll
        for (int a = 0; a < 2; ++a)
#pragma unroll
            for (int b = 0; b < 2; ++b)
#pragma unroll
                for (int m = 0; m < 4; ++m)
#pragma unroll
                    for (int n = 0; n < 2; ++n) acc[a][b][m][n] = (f32x4){0.f, 0.f, 0.f, 0.f};
        cur = nxt; cA = nA; cB = nB; ++ui;
        if constexpr (ALIGN_EPI) { if (wr == 1) PG8_BAR; }
    }
    PG8_WAIT_V(0);
    if constexpr (!ALIGN_EPI) { if (wr == 0) PG8_BAR; }
    PG8_BAR;
    if constexpr (Epi::AFTER_DRAIN) { E.fused(acc, cur, wr, wc, fr, fq, lds, wid, lane); S.done(cur); }
#undef PG8_SA
#undef PG8_SB
#undef PG8_STAGE
#undef PG8_LDA
#undef PG8_LDB
#undef PG8_MMA
#undef PG8_WAIT_V
#undef PG8_WAIT_L
#undef PG8_BAR
#undef PG8_SCHED
}
}

#define LAS __attribute__((address_space(3)))
typedef unsigned short bf16;
typedef short bf16x8 __attribute__((ext_vector_type(8)));
typedef short s16x4 __attribute__((ext_vector_type(4)));
typedef float f32x4 __attribute__((ext_vector_type(4)));
typedef float f32x2 __attribute__((ext_vector_type(2)));
typedef unsigned u32x4 __attribute__((ext_vector_type(4)));
typedef unsigned u32x2 __attribute__((ext_vector_type(2)));

constexpr int DM = 2048, SEQ = 8192, NB = 2, CTX = 256;
constexpr int ML = NB * SEQ;
constexpr int MC = NB * CTX;
constexpr int MT = ML + MC;
constexpr int INC = 12320;
constexpr int PS = 12288;
constexpr int NINP = 12544;
constexpr int FF = 5632;
constexpr int ADA = 6 * DM;
constexpr int C_AIN = 0, C_AB = 512, C_AC = 1024, C_GQ = 1536, C_GK = 1920, C_GV = 2304, C_GR = 3072, C_NQ = 3840, C_NK = 4608, C_NV = 5376, C_GATE = 6144;
constexpr int NCH = 132;

constexpr size_t MiB = 1u << 20;
constexpr size_t WS_MADA = 1 * MiB, WS_HC = 2 * MiB, WS_ALPHA = 6 * MiB, WS_DBUF = 9 * MiB, WS_NBUF = 10 * MiB;
constexpr size_t WS_BR = 76 * MiB;
constexpr size_t WS_P = 142 * MiB, WS_UBUF = 538 * MiB;
constexpr size_t WS_WIN = 637 * MiB, WS_W13 = 686 * MiB, WS_W2 = 730 * MiB, WS_WO = 752 * MiB, WS_WM = 760 * MiB, WS_END = 768 * MiB;
static_assert(WS_BR + (size_t)MT * DM * 2 <= WS_P, "ws map");
static_assert(WS_P + (size_t)MT * PS * 2 <= WS_UBUF, "ws map");
static_assert(WS_UBUF + (size_t)24 * NCH * 8192 * 4 <= WS_WIN, "ws map");

constexpr int LDS_BYTES = 147456;

struct Params {
    const float *x, *c, *ctx, *c_ctx, *w_ada, *b_ada, *g_mix, *g_ffn, *w_in, *conv_w, *wa_f, *ba_f, *wa_b, *ba_b, *g_norm, *rpb,
                *w_a_out, *w_g_out, *w_n_out, *w_o, *w1, *w3, *w2, *g_final;
    float* out; unsigned char* ws;
};

__device__ __forceinline__ float bf2f(unsigned short v) { return __builtin_bit_cast(float, (unsigned)v << 16); }
__device__ __forceinline__ float bflo(unsigned v) { return __builtin_bit_cast(float, v << 16); }
__device__ __forceinline__ float bfhi(unsigned v) { return __builtin_bit_cast(float, v & 0xffff0000u); }
__device__ __forceinline__ unsigned f2bf(float f) { unsigned u = __builtin_bit_cast(unsigned, f); return (u + 0x7fffu + ((u >> 16) & 1u)) >> 16; }
typedef __bf16 bf16x2_t __attribute__((ext_vector_type(2)));
__device__ __forceinline__ unsigned pk2(float lo, float hi) { f32x2 v = {lo, hi}; bf16x2_t b = __builtin_convertvector(v, bf16x2_t); return __builtin_bit_cast(unsigned, b); }
__device__ __forceinline__ float fast_exp(float x) { return __builtin_amdgcn_exp2f(x * 1.4426950408889634f); }
__device__ __forceinline__ float fast_rcp(float x) { return __builtin_amdgcn_rcpf(x); }
__device__ __forceinline__ float sigmoidf_(float x) { return fast_rcp(1.f + fast_exp(-x)); }
__device__ __forceinline__ float siluf_(float x) { return x * sigmoidf_(x); }
__device__ __forceinline__ float wave_sum(float v) {
#pragma unroll
    for (int o = 1; o < 64; o <<= 1) v += __shfl_xor(v, o);
    return v;
}
__device__ __forceinline__ float xrow16_max(float x) {
    auto s = __builtin_amdgcn_permlane16_swap(__float_as_uint(x), __float_as_uint(x), false, false);
    x = fmaxf(__uint_as_float(s[0]), __uint_as_float(s[1]));
    auto t = __builtin_amdgcn_permlane32_swap(__float_as_uint(x), __float_as_uint(x), false, false);
    return fmaxf(__uint_as_float(t[0]), __uint_as_float(t[1]));
}
__device__ __forceinline__ float xrow16_sum(float x) {
    auto s = __builtin_amdgcn_permlane16_swap(__float_as_uint(x), __float_as_uint(x), false, false);
    x = __uint_as_float(s[0]) + __uint_as_float(s[1]);
    auto t = __builtin_amdgcn_permlane32_swap(__float_as_uint(x), __float_as_uint(x), false, false);
    return __uint_as_float(t[0]) + __uint_as_float(t[1]);
}
__device__ __forceinline__ s16x4 tr_read(const LAS bf16* p) {
    typedef short v4i16_t __attribute__((ext_vector_type(4)));
    return __builtin_bit_cast(s16x4, __builtin_amdgcn_ds_read_tr16_b64_v4i16((LAS v4i16_t*)p));
}
__device__ __forceinline__ bf16x8 cat4(s16x4 a, s16x4 b) { return (bf16x8){a[0], a[1], a[2], a[3], b[0], b[1], b[2], b[3]}; }
#define MFMA16(X, Y, C) __builtin_amdgcn_mfma_f32_16x16x32_bf16((X), (Y), (C), 0, 0, 0)

namespace pg8 {
struct EpiInproj {
    static constexpr bool PERM = true, AFTER_DRAIN = false, MIDHOOK = false;
    bf16_t* P; float* alpha;
    __device__ __forceinline__ void operator()(const f32x4 (&acc)[2][2][4][2], const Unit& u, int wr, int wc, int fr, int fq) const {
        const int row0 = u.pm * 256 + wr * 64 + fr;
        if (u.pn < 48) {
            const bool sg = u.pn >= 24;
            const int col0 = u.pn * 256 + wc * 32 + 8 * fq;
#pragma unroll
            for (int ai = 0; ai < 2; ++ai)
#pragma unroll
                for (int m = 0; m < 4; ++m) {
                    bf16_t* rowp = P + (size_t)(row0 + ai * 128 + m * 16) * PS + col0;
#pragma unroll
                    for (int bj = 0; bj < 2; ++bj) {
                        f32x4 v0 = acc[ai][bj][m][0], v1 = acc[ai][bj][m][1];
                        if (sg) {
#pragma unroll
                            for (int e = 0; e < 4; ++e) { v0[e] = sigmoidf_(v0[e]); v1[e] = sigmoidf_(v1[e]); }
                        }
                        u32x4 w; w.x = pk2(v0[0], v0[1]); w.y = pk2(v0[2], v0[3]); w.z = pk2(v1[0], v1[1]); w.w = pk2(v1[2], v1[3]);
                        *(u32x4*)(rowp + bj * 128) = w;
                    }
                }
        } else if (wc == 0) {
#pragma unroll
            for (int ai = 0; ai < 2; ++ai)
#pragma unroll
                for (int m = 0; m < 4; ++m) {
                    float* ap = alpha + (size_t)(row0 + ai * 128 + m * 16) * 32 + 8 * fq;
                    *(f32x4*)ap = acc[ai][0][m][0]; *(f32x4*)(ap + 4) = acc[ai][0][m][1];
                }
        }
    }
};

struct EpiMerge {
    static constexpr bool PERM = true, AFTER_DRAIN = false, MIDHOOK = true;
    const bf16_t* P; bf16_t* Yb;
    __device__ __forceinline__ void mid(f32x4 (&acc)[2][2][4][2], const Unit& u, int wr, int wc, int fr, int fq, int t) const {
        int fr_ = fr; asm volatile("" : "+v"(fr_));
        const int row0 = u.pm * 256 + wr * 64 + fr_, col0 = u.pn * 256 + wc * 32 + 8 * fq, noff = C_GATE + (t == 8 ? 0 : 2048);
#pragma unroll
        for (int ai = 0; ai < 2; ++ai)
#pragma unroll
            for (int m = 0; m < 4; ++m) {
                const bf16_t* gp = P + (size_t)(row0 + ai * 128 + m * 16) * PS + noff + col0;
#pragma unroll
                for (int bj = 0; bj < 2; ++bj) {
                    const u32x4 gn = *(const u32x4*)(gp + bj * 128), gd = *(const u32x4*)(gp + bj * 128 + 2048);
                    f32x4 r0, r1;
                    r0[0] = bflo(gn.x) * fast_rcp(fmaxf(bflo(gd.x), 1e-20f)); r0[1] = bfhi(gn.x) * fast_rcp(fmaxf(bfhi(gd.x), 1e-20f));
                    r0[2] = bflo(gn.y) * fast_rcp(fmaxf(bflo(gd.y), 1e-20f)); r0[3] = bfhi(gn.y) * fast_rcp(fmaxf(bfhi(gd.y), 1e-20f));
                    r1[0] = bflo(gn.z) * fast_rcp(fmaxf(bflo(gd.z), 1e-20f)); r1[1] = bfhi(gn.z) * fast_rcp(fmaxf(bfhi(gd.z), 1e-20f));
                    r1[2] = bflo(gn.w) * fast_rcp(fmaxf(bflo(gd.w), 1e-20f)); r1[3] = bfhi(gn.w) * fast_rcp(fmaxf(bfhi(gd.w), 1e-20f));
                    acc[ai][bj][m][0] *= r0; acc[ai][bj][m][1] *= r1;
                }
                if (m == 1 || m == 3) __builtin_amdgcn_sched_barrier(0);
            }
    }
    __device__ __forceinline__ void operator()(const f32x4 (&acc)[2][2][4][2], const Unit& u, int wr, int wc, int fr, int fq) const {
        const int row0 = u.pm * 256 + wr * 64 + fr, col0 = u.pn * 256 + wc * 32 + 8 * fq;
#pragma unroll
        for (int ai = 0; ai < 2; ++ai)
#pragma unroll
            for (int m = 0; m < 4; ++m) {
                const size_t row = (size_t)(row0 + ai * 128 + m * 16);
#pragma unroll
                for (int bj = 0; bj < 2; ++bj) {
                    const int col = col0 + bj * 128;
                    const u32x4 g = *(const u32x4*)(P + row * PS + C_GATE + 4096 + col);
                    f32x4 v0 = acc[ai][bj][m][0], v1 = acc[ai][bj][m][1];
                    v0[0] *= fmaxf(bflo(g.x), 1e-20f); v0[1] *= fmaxf(bfhi(g.x), 1e-20f); v0[2] *= fmaxf(bflo(g.y), 1e-20f); v0[3] *= fmaxf(bfhi(g.y), 1e-20f);
                    v1[0] *= fmaxf(bflo(g.z), 1e-20f); v1[1] *= fmaxf(bfhi(g.z), 1e-20f); v1[2] *= fmaxf(bflo(g.w), 1e-20f); v1[3] *= fmaxf(bfhi(g.w), 1e-20f);
                    u32x4 w; w.x = pk2(v0[0], v0[1]); w.y = pk2(v0[2], v0[3]); w.z = pk2(v1[0], v1[1]); w.w = pk2(v1[2], v1[3]);
                    *(u32x4*)(Yb + row * DM + col) = w;
                }
            }
    }
};

struct EpiResid {
    static constexpr bool PERM = true, AFTER_DRAIN = false, MIDHOOK = false;
    const float* srcL; float* dstL; const float* srcC; float* dstC; const float* gate;
    __device__ __forceinline__ void operator()(const f32x4 (&acc)[2][2][4][2], const Unit& u, int wr, int wc, int fr, int fq) const {
        const bool isc = u.pm >= 64;
        const int row0 = (isc ? (u.pm - 64) * 256 : u.pm * 256) + wr * 64 + fr, col0 = u.pn * 256 + wc * 32 + 8 * fq;
        const float* src = isc ? srcC : srcL; float* dst = isc ? dstC : dstL;
        const float* gv = gate + (isc ? 2 : (u.pm >> 5)) * ADA;
#pragma unroll
        for (int bj = 0; bj < 2; ++bj) {
            const int col = col0 + bj * 128;
            const f32x4 g0 = *(const f32x4*)(gv + col), g1 = *(const f32x4*)(gv + col + 4);
#pragma unroll
            for (int ai = 0; ai < 2; ++ai)
#pragma unroll
                for (int m = 0; m < 4; ++m) {
                    const size_t off = (size_t)(row0 + ai * 128 + m * 16) * DM + col;
                    const f32x4 s0 = *(const f32x4*)(src + off), s1 = *(const f32x4*)(src + off + 4);
                    *(f32x4*)(dst + off) = s0 + g0 * acc[ai][bj][m][0];
                    *(f32x4*)(dst + off + 4) = s1 + g1 * acc[ai][bj][m][1];
                }
        }
    }
};

struct EpiSwiglu {
    static constexpr bool PERM = true, AFTER_DRAIN = false, MIDHOOK = false;
    bf16_t* H;
    __device__ __forceinline__ void operator()(const f32x4 (&acc)[2][2][4][2], const Unit& u, int wr, int wc, int fr, int fq) const {
        const int row0 = u.pm * 256 + wr * 64 + fr, col0 = u.pn * 128 + wc * 32 + 8 * fq;
#pragma unroll
        for (int ai = 0; ai < 2; ++ai)
#pragma unroll
            for (int m = 0; m < 4; ++m) {
                f32x4 v0 = acc[ai][0][m][0], v1 = acc[ai][0][m][1];
                const f32x4 t0 = acc[ai][1][m][0], t1 = acc[ai][1][m][1];
#pragma unroll
                for (int e = 0; e < 4; ++e) { v0[e] = siluf_(v0[e]) * t0[e]; v1[e] = siluf_(v1[e]) * t1[e]; }
                u32x4 w; w.x = pk2(v0[0], v0[1]); w.y = pk2(v0[2], v0[3]); w.z = pk2(v1[0], v1[1]); w.w = pk2(v1[2], v1[3]);
                *(u32x4*)(H + (size_t)(row0 + ai * 128 + m * 16) * FF + col0) = w;
            }
    }
};

struct EpiPartial {
    static constexpr bool PERM = true, AFTER_DRAIN = false, MIDHOOK = false;
    float* part; const float* gv; int kloop;
    __device__ __forceinline__ void operator()(const f32x4 (&acc)[2][2][4][2], const Unit& u, int wr, int wc, int fr, int fq) const {
        const int row0 = u.pm * 256 + wr * 64 + fr, col0 = u.pn * 256 + wc * 32 + 8 * fq;
        float* dst = part + (size_t)(u.ko / kloop) * MC * DM;
#pragma unroll
        for (int bj = 0; bj < 2; ++bj) {
            const int col = col0 + bj * 128;
            const f32x4 g0 = *(const f32x4*)(gv + col), g1 = *(const f32x4*)(gv + col + 4);
#pragma unroll
            for (int ai = 0; ai < 2; ++ai)
#pragma unroll
                for (int m = 0; m < 4; ++m) {
                    const size_t off = (size_t)(row0 + ai * 128 + m * 16) * DM + col;
                    *(f32x4*)(dst + off) = g0 * acc[ai][bj][m][0];
                    *(f32x4*)(dst + off + 4) = g1 * acc[ai][bj][m][1];
                }
        }
    }
};
}
#define XB_TMO      128
#define XB_XCNT(j)  (256  + 64 * (j))
#define XB_XSUB(j)  (1280 + 64 * (j))
#define XB_XGEN(j)  (2304 + 64 * (j))
#define XB_TOP      3328
#define XB_TOPGEN   3392
#define XCD_BAR_WORDS 3456
#define XB_SPIN_CAP (1u << 18)

__device__ __forceinline__ unsigned xb_ld(unsigned* p)              { return __hip_atomic_load(p, __ATOMIC_RELAXED, __HIP_MEMORY_SCOPE_AGENT); }
__device__ __forceinline__ unsigned xb_add(unsigned* p, unsigned v) { return __hip_atomic_fetch_add(p, v, __ATOMIC_RELAXED, __HIP_MEMORY_SCOPE_AGENT); }
__device__ __forceinline__ unsigned xb_xcc_id() { return (unsigned)__builtin_amdgcn_s_getreg((3 << 11) | 20) & 0xFu; }
#define XB_SPIN(cond, bar) do { unsigned _sp = 0; while (cond) { __builtin_amdgcn_s_sleep(1); \
    if ((++_sp & 255u) == 0u) { if (xb_ld(&(bar)[XB_TMO])) break; if (_sp > XB_SPIN_CAP) { atomicAdd(&(bar)[XB_TMO], 1u); break; } } } } while (0)

struct XcdBarrier {
    unsigned* bar; unsigned x;
    volatile LAS unsigned* st;
};

__device__ __forceinline__ XcdBarrier xcd_barrier_post(unsigned* bar, volatile LAS unsigned* st) {
    XcdBarrier b; b.bar = bar; b.x = xb_xcc_id(); b.st = st;
    if (threadIdx.x == 0) (void)xb_add(&bar[XB_XCNT(b.x)], 1u);
    return b;
}
__device__ __forceinline__ void xcd_barrier_complete(unsigned* bar, unsigned x, unsigned& nloc, unsigned& nx) {
    const unsigned G = gridDim.x * gridDim.y * gridDim.z;
    unsigned sum, cnt, mine, sp = 0u;
    for (;;) {
        sum = 0u; cnt = 0u; mine = 0u;
#pragma unroll
        for (unsigned j = 0; j < 16; ++j) { const unsigned c = xb_ld(&bar[XB_XCNT(j)]); sum += c; cnt += (c > 0u) ? 1u : 0u; mine = (j == x) ? c : mine; }
        if (sum == G) break;
        __builtin_amdgcn_s_sleep(1);
        if ((++sp & 255u) == 0u) { if (xb_ld(&bar[XB_TMO])) break; if (sp > XB_SPIN_CAP) { atomicAdd(&bar[XB_TMO], 1u); break; } }
    }
    nloc = mine > 0u ? mine : 1u; nx = cnt > 0u ? cnt : 1u;
}

__device__ __forceinline__ void xcd_barrier(const XcdBarrier& b) {
    asm volatile("s_waitcnt vmcnt(0)" ::: "memory");
    __syncthreads();
    if (threadIdx.x == 0) {
        unsigned* bar = b.bar;
        __builtin_amdgcn_s_waitcnt(0);
        unsigned nloc = b.st[0], nx = b.st[1];
        if (nloc == 0u) { xcd_barrier_complete(bar, b.x, nloc, nx); b.st[0] = nloc; b.st[1] = nx; }
        const unsigned old = xb_add(&bar[XB_XSUB(b.x)], 1u);
        const unsigned gen = old / nloc;
        if (old + 1u == (gen + 1u) * nloc) {
            __builtin_amdgcn_fence(__ATOMIC_RELEASE, "agent");
            asm volatile("s_waitcnt vmcnt(0)" ::: "memory");
            const unsigned og = xb_add(&bar[XB_TOP], 1u);
            const unsigned tg = og / nx;
            if (og + 1u == (tg + 1u) * nx) xb_add(&bar[XB_TOPGEN], 1u);
            else XB_SPIN(xb_ld(&bar[XB_TOPGEN]) == tg, bar);
            __builtin_amdgcn_fence(__ATOMIC_ACQUIRE, "agent");
            xb_add(&bar[XB_XGEN(b.x)], 1u);
            asm volatile("s_waitcnt vmcnt(0)" ::: "memory");
        } else {
            XB_SPIN(xb_ld(&bar[XB_XGEN(b.x)]) == gen, bar);
            __builtin_amdgcn_fence(__ATOMIC_ACQUIRE, "agent");
            asm volatile("s_waitcnt vmcnt(0)" ::: "memory");
        }
    }
    __syncthreads();
}

__device__ __forceinline__ void transpose_item(const float* W, int K, int Nsrc, int src_n0, bf16* WT, int dst_n0, int k0, LAS float* scr, int lane, int dpitch = 0, int dk0 = 0) {
    if (!dpitch) dpitch = K;
    if (W) {
#pragma unroll 8
        for (int i = 0; i < 32; ++i) { const int kk = 2 * i + (lane >> 5); scr[kk * 33 + (lane & 31)] = __builtin_nontemporal_load(W + (size_t)(k0 + kk) * Nsrc + src_n0 + (lane & 31)); }
    } else {
#pragma unroll 8
        for (int i = 0; i < 32; ++i) { const int kk = 2 * i + (lane >> 5); scr[kk * 33 + (lane & 31)] = 0.f; }
    }
    asm volatile("s_waitcnt lgkmcnt(0)" ::: "memory");
    const int c = lane & 7;
#pragma unroll
    for (int j = 0; j < 4; ++j) { const int n = (lane >> 3) + 8 * j; const LAS float* s = scr + (8 * c) * 33 + n;
        u32x4 o; o.x = pk2(s[0 * 33], s[1 * 33]); o.y = pk2(s[2 * 33], s[3 * 33]); o.z = pk2(s[4 * 33], s[5 * 33]); o.w = pk2(s[6 * 33], s[7 * 33]);
        *(u32x4*)(WT + (size_t)(dst_n0 + n) * dpitch + dk0 + k0 + 8 * c) = o; }
    asm volatile("s_waitcnt lgkmcnt(0)" ::: "memory");
}

__device__ __forceinline__ void convert_weights(const Params& p, int l, LAS unsigned char* lds, int gw, int NGW, int wave, int lane) {
    LAS float* scr = (LAS float*)(lds + wave * 16384);
    unsigned char* ws = p.ws;
    constexpr int I_IN = 32 * 392, I_13 = 32 * 352, I_2 = 88 * 64, I_O = 32 * 64, I_A = 8 * 64, I_G = 12 * 64, I_N = 12 * 64;
    constexpr int NIT = I_IN + I_13 + I_2 + I_O + I_A + I_G + I_N;
    for (int it = gw; it < NIT; it += NGW) {
        int r = it;
        if (r < I_IN) { const int kb = r / 392, nb = r % 392; const float* W = p.w_in + (size_t)l * DM * INC;
            int sb; if (nb < 120) sb = nb; else if (nb < 384) sb = nb + 1; else if (nb == 384) sb = 120; else sb = -1;
            transpose_item(sb >= 0 ? W : nullptr, DM, INC, sb * 32, (bf16*)(ws + WS_WIN), nb * 32, kb * 64, scr, lane); continue; } r -= I_IN;
        if (r < I_13) { const int kb = r / 352, nb = r % 352, pn = nb >> 3, wi = nb & 7;
            const float* W = ((wi >> 2) ? p.w3 : p.w1) + (size_t)l * DM * FF;
            transpose_item(W, DM, FF, (pn * 4 + (wi & 3)) * 32, (bf16*)(ws + WS_W13), nb * 32, kb * 64, scr, lane); continue; } r -= I_13;
        if (r < I_2) { const int kb = r / 64, nb = r % 64; transpose_item(p.w2 + (size_t)l * FF * DM, FF, DM, nb * 32, (bf16*)(ws + WS_W2), nb * 32, kb * 64, scr, lane); continue; } r -= I_2;
        if (r < I_O) { const int kb = r / 64, nb = r % 64; transpose_item(p.w_o + (size_t)l * DM * DM, DM, DM, nb * 32, (bf16*)(ws + WS_WO), nb * 32, kb * 64, scr, lane); continue; } r -= I_O;
        if (r < I_A) { const int kb = r / 64, nb = r % 64; transpose_item(p.w_a_out + (size_t)l * 512 * DM, 512, DM, nb * 32, (bf16*)(ws + WS_WM), nb * 32, kb * 64, scr, lane, DM, 0); continue; } r -= I_A;
        if (r < I_G) { const int kb = r / 64, nb = r % 64; transpose_item(p.w_g_out + (size_t)l * 768 * DM, 768, DM, nb * 32, (bf16*)(ws + WS_WM), nb * 32, kb * 64, scr, lane, DM, 512); continue; } r -= I_G;
        { const int kb = r / 64, nb = r % 64; transpose_item(p.w_n_out + (size_t)l * 768 * DM, 768, DM, nb * 32, (bf16*)(ws + WS_WM), nb * 32, kb * 64, scr, lane, DM, 1280); }
    }
}

__device__ __forceinline__ void adaln_item(const Params& p, int item, LAS unsigned char* lds, int tid, int wave, int lane) {
    const int l = item / 96, cb = item % 96;
    LAS float* sl = (LAS float*)lds;
    LAS float* red = (LAS float*)(lds + 24576);
    __syncthreads();
    for (int i = tid; i < 3 * DM; i += 512) { const int v = i / DM, k = i % DM; const float cv = v < 2 ? p.c[v * DM + k] : p.c_ctx[k]; sl[i] = siluf_(cv); }
    __syncthreads();
    const float* W = p.w_ada + (size_t)l * DM * ADA + cb * 128 + 2 * lane;
    float a00 = 0, a01 = 0, a10 = 0, a11 = 0, a20 = 0, a21 = 0;
    const int kbeg = wave * 256;
#pragma unroll 8
    for (int k = kbeg; k < kbeg + 256; ++k) {
        const f32x2 w = __builtin_nontemporal_load((const f32x2*)(W + (size_t)k * ADA));
        const float s0 = sl[k], s1 = sl[DM + k], s2 = sl[2 * DM + k];
        a00 += s0 * w.x; a01 += s0 * w.y; a10 += s1 * w.x; a11 += s1 * w.y; a20 += s2 * w.x; a21 += s2 * w.y;
    }
    red[(wave * 3 + 0) * 128 + 2 * lane] = a00; red[(wave * 3 + 0) * 128 + 2 * lane + 1] = a01;
    red[(wave * 3 + 1) * 128 + 2 * lane] = a10; red[(wave * 3 + 1) * 128 + 2 * lane + 1] = a11;
    red[(wave * 3 + 2) * 128 + 2 * lane] = a20; red[(wave * 3 + 2) * 128 + 2 * lane + 1] = a21;
    __syncthreads();
    if (tid < 384) { const int v = tid / 128, j = tid % 128; float s = p.b_ada[l * ADA + cb * 128 + j];
#pragma unroll
        for (int w = 0; w < 8; ++w) s += red[(w * 3 + v) * 128 + j];
        ((float*)(p.ws + WS_MADA))[(size_t)(l * 3 + v) * ADA + cb * 128 + j] = s; }
}

__device__ __forceinline__ void norm_rows(const float* srcL, const float* srcC, const float* g, const float* mv, int sc_idx, int sh_idx, bf16* out, int nrows, int gw, int NGW, int lane, const float* part, int nsplit, float* wb) {
    for (int row = gw; row < nrows; row += NGW) {
        const bool isc = row >= ML;
        const f32x4* src = (const f32x4*)(isc ? srcC + (size_t)(row - ML) * DM : srcL + (size_t)row * DM) + lane;
        const float* mvv = mv + (isc ? 2 : (row >> 13)) * ADA;
        f32x4 v[8]; float s = 0.f;
#pragma unroll
        for (int j = 0; j < 8; ++j) v[j] = src[64 * j];
        if (isc && nsplit > 0) {
            const f32x4* pp = (const f32x4*)(part + (size_t)(row - ML) * DM) + lane;
#pragma unroll 4
            for (int sp = 0; sp < nsplit; ++sp) {
#pragma unroll
                for (int j = 0; j < 8; ++j) v[j] += pp[(size_t)sp * (MC * DM / 4) + 64 * j];
            }
            if (wb) { f32x4* w4 = (f32x4*)(wb + (size_t)(row - ML) * DM) + lane;
#pragma unroll
                for (int j = 0; j < 8; ++j) w4[64 * j] = v[j]; }
        }
#pragma unroll
        for (int j = 0; j < 8; ++j) s += (v[j].x * v[j].x + v[j].y * v[j].y) + (v[j].z * v[j].z + v[j].w * v[j].w);
        const float rstd = 1.f / sqrtf(wave_sum(s) * (1.f / DM) + 1e-6f);
        u32x2* o = (u32x2*)(out + (size_t)row * DM) + lane;
#pragma unroll
        for (int j = 0; j < 8; ++j) {
            const int col = 4 * (lane + 64 * j);
            const f32x4 gg = *(const f32x4*)(g + col), sc = *(const f32x4*)(mvv + sc_idx * DM + col), sh = *(const f32x4*)(mvv + sh_idx * DM + col);
            const f32x4 y = (v[j] * rstd) * gg * (sc + 1.f) + sh;
            u32x2 w; w.x = pk2(y.x, y.y); w.y = pk2(y.z, y.w); o[64 * j] = w;
        }
    }
}
__device__ __forceinline__ void final_norm(float* h, const float* g, int gw, int NGW, int lane) {
    for (int row = gw; row < ML; row += NGW) {
        f32x4* src = (f32x4*)(h + (size_t)row * DM) + lane;
        f32x4 v[8]; float s = 0.f;
#pragma unroll
        for (int j = 0; j < 8; ++j) { v[j] = src[64 * j]; s += (v[j].x * v[j].x + v[j].y * v[j].y) + (v[j].z * v[j].z + v[j].w * v[j].w); }
        const float rstd = 1.f / sqrtf(wave_sum(s) * (1.f / DM) + 1e-6f);
#pragma unroll
        for (int j = 0; j < 8; ++j) { const f32x4 gg = *(const f32x4*)(g + 4 * (lane + 64 * j)); __builtin_nontemporal_store((v[j] * rstd) * gg, src + 64 * j); }
    }
}

__device__ __forceinline__ void conv_loadu(const bf16* P, int row, int seq0, int seqlen, int ch, float (&u)[8]) {
    const int t = row - seq0;
    if (t < 0 || t >= seqlen) {
#pragma unroll
        for (int i = 0; i < 8; ++i) u[i] = 0.f;
    } else {
        const u32x4 a = *(const u32x4*)(P + (size_t)row * PS + C_AIN + ch), c = *(const u32x4*)(P + (size_t)row * PS + C_AC + ch);
        u[0] = bflo(a.x) * bflo(c.x); u[1] = bfhi(a.x) * bfhi(c.x); u[2] = bflo(a.y) * bflo(c.y); u[3] = bfhi(a.y) * bfhi(c.y);
        u[4] = bflo(a.z) * bflo(c.z); u[5] = bfhi(a.z) * bfhi(c.z); u[6] = bflo(a.w) * bflo(c.w); u[7] = bfhi(a.w) * bfhi(c.w);
    }
}
__device__ __forceinline__ void conv_item(const bf16* P, const float* cw, bf16* A, int item, int tid) {
    const int rbase = item * 64, ch = (tid & 63) * 8, r0 = rbase + (tid >> 6) * 8;
    const int seqlen = rbase >= ML ? CTX : SEQ, seq0 = rbase >= ML ? ML + ((rbase - ML) / CTX) * CTX : (rbase / SEQ) * SEQ;
    float w0[8], w1[8], w2[8];
#pragma unroll
    for (int i = 0; i < 8; ++i) { w0[i] = cw[ch + i]; w1[i] = cw[512 + ch + i]; w2[i] = cw[1024 + ch + i]; }
    float up[8], uc[8], un[8];
    conv_loadu(P, r0 - 1, seq0, seqlen, ch, up); conv_loadu(P, r0, seq0, seqlen, ch, uc);
#pragma unroll
    for (int r = 0; r < 8; ++r) {
        conv_loadu(P, r0 + r + 1, seq0, seqlen, ch, un);
        const u32x4 b = *(const u32x4*)(P + (size_t)(r0 + r) * PS + C_AB + ch);
        float o[8];
#pragma unroll
        for (int i = 0; i < 8; ++i) o[i] = w0[i] * up[i] + w1[i] * uc[i] + w2[i] * un[i];
        o[0] *= bflo(b.x); o[1] *= bfhi(b.x); o[2] *= bflo(b.y); o[3] *= bfhi(b.y); o[4] *= bflo(b.z); o[5] *= bfhi(b.z); o[6] *= bflo(b.w); o[7] *= bfhi(b.w);
        u32x4 w; w.x = pk2(o[0], o[1]); w.y = pk2(o[2], o[3]); w.z = pk2(o[4], o[5]); w.w = pk2(o[6], o[7]);
        *(u32x4*)(A + (size_t)(r0 + r) * DM + ch) = w;
#pragma unroll
        for (int i = 0; i < 8; ++i) { up[i] = uc[i]; uc[i] = un[i]; }
    }
}

struct NaQ { bf16x8 qf[4]; f32x4 o[8]; float m, l; };
template <int NJ> __device__ __forceinline__ void na_softmax(f32x4 (&s)[NJ], float mx, NaQ& Q) {
    mx = xrow16_max(mx);
    const float mnew = fmaxf(Q.m, mx), alpha = __builtin_amdgcn_exp2f(Q.m - mnew); Q.m = mnew;
    float ps = 0.f;
#pragma unroll
    for (int t = 0; t < NJ; ++t)
#pragma unroll
        for (int e = 0; e < 4; ++e) { const float pe = __builtin_amdgcn_exp2f(s[t][e] - mnew); s[t][e] = pe; ps += pe; }
    Q.l = Q.l * alpha + ps;
    if (__builtin_amdgcn_ballot_w64(alpha != 1.f) != 0ull) {
#pragma unroll
        for (int i = 0; i < 8; ++i) Q.o[i] *= alpha;
    }
}
template <bool ISL, bool DOA, bool DOB>
__device__ __forceinline__ void na_block(const LAS bf16* Ks, const LAS bf16* Vs, NaQ& A, NaQ& B, int ja, int jb, int fr, int fq, const LAS float* bpA, const LAS float* bpB, int cs, float scale2) {
    constexpr int NJ = 2;
    f32x4 sA[NJ], sB[NJ]; float mxA = -INFINITY, mxB = -INFINITY;
#pragma unroll
    for (int t = 0; t < NJ; ++t) {
        const int j = t ? jb : ja;
        sA[t] = (f32x4){0.f, 0.f, 0.f, 0.f}; sB[t] = (f32x4){0.f, 0.f, 0.f, 0.f};
        const LAS bf16* kp = Ks + (16 * j + fr) * 136 + 8 * fq;
#pragma unroll
        for (int kk = 0; kk < 4; ++kk) { const bf16x8 X = *(const LAS bf16x8*)(kp + 32 * kk);
            if (DOA) sA[t] = MFMA16(X, A.qf[kk], sA[t]);
            if (DOB) sB[t] = MFMA16(X, B.qf[kk], sB[t]); }
#pragma unroll
        for (int e = 0; e < 4; ++e) {
            if (ISL) { const int kc = 16 * j + 4 * fq + e; const bool valid = (unsigned)(kc - cs) < 16u; const int bi = valid ? kc : 0;
                if (DOA) { const float bv = bpA[bi]; const float v = valid ? sA[t][e] * scale2 + bv : -INFINITY; sA[t][e] = v; mxA = fmaxf(mxA, v); }
                if (DOB) { const float bv = bpB[bi]; const float v = valid ? sB[t][e] * scale2 + bv : -INFINITY; sB[t][e] = v; mxB = fmaxf(mxB, v); }
            } else {
                if (DOA) { const float v = sA[t][e] * scale2; sA[t][e] = v; mxA = fmaxf(mxA, v); }
                if (DOB) { const float v = sB[t][e] * scale2; sB[t][e] = v; mxB = fmaxf(mxB, v); }
            }
        }
        __builtin_amdgcn_sched_barrier(0);
    }
    if (DOA) na_softmax<NJ>(sA, mxA, A);
    if (DOB) na_softmax<NJ>(sB, mxB, B);
#pragma unroll
    for (int g2 = 0; g2 < NJ / 2; ++g2) {
        const int j0 = ja, j1 = jb;
        bf16x8 YA = (bf16x8){0, 0, 0, 0, 0, 0, 0, 0}, YB = YA;
        if (DOA) { u32x4 yw; yw.x = pk2(sA[2 * g2][0], sA[2 * g2][1]); yw.y = pk2(sA[2 * g2][2], sA[2 * g2][3]); yw.z = pk2(sA[2 * g2 + 1][0], sA[2 * g2 + 1][1]); yw.w = pk2(sA[2 * g2 + 1][2], sA[2 * g2 + 1][3]); YA = __builtin_bit_cast(bf16x8, yw); }
        if (DOB) { u32x4 yw; yw.x = pk2(sB[2 * g2][0], sB[2 * g2][1]); yw.y = pk2(sB[2 * g2][2], sB[2 * g2][3]); yw.z = pk2(sB[2 * g2 + 1][0], sB[2 * g2 + 1][1]); yw.w = pk2(sB[2 * g2 + 1][2], sB[2 * g2 + 1][3]); YB = __builtin_bit_cast(bf16x8, yw); }
        const LAS bf16* v0 = Vs + (16 * j0 + 4 * fq + (fr >> 2)) * 136 + 4 * (fr & 3);
        const LAS bf16* v1 = Vs + (16 * j1 + 4 * fq + (fr >> 2)) * 136 + 4 * (fr & 3);
#pragma unroll
        for (int dvb = 0; dvb < 8; ++dvb) { const bf16x8 X = cat4(tr_read(v0 + 16 * dvb), tr_read(v1 + 16 * dvb));
            if (DOA) A.o[dvb] = MFMA16(X, YA, A.o[dvb]);
            if (DOB) B.o[dvb] = MFMA16(X, YB, B.o[dvb]);
            if ((dvb & 3) == 3) __builtin_amdgcn_sched_barrier(0); }
    }
}
__device__ __forceinline__ void na_store(const NaQ& Q, bf16* O, size_t qrow, int h, int fq) {
    const float l = xrow16_sum(Q.l);
    const float inv = 1.f / l;
#pragma unroll
    for (int dvb = 0; dvb < 8; ++dvb) { u32x2 w; w.x = pk2(Q.o[dvb][0] * inv, Q.o[dvb][1] * inv); w.y = pk2(Q.o[dvb][2] * inv, Q.o[dvb][3] * inv);
        *(u32x2*)(O + qrow * DM + 1280 + h * 128 + 16 * dvb + 4 * fq) = w; }
}
__device__ __forceinline__ void na_item(LAS unsigned char* lds, const bf16* P, const float* rpb, bf16* O, int b, int h, int rp, int qhalf, int tid, int wave, int lane) {
    LAS float* bias = (LAS float*)(lds + 69632);
    const int fr = lane & 15, fq = lane >> 4, g = wave & 3;
    const bool loc = rp >= 0;
    int rA = 0, qc = 0, cs = 0, ja = 0, jb = 1, rsA = 0, kr_lo = 0, nloc = 0; size_t qrowA;
    if (loc) { rA = 2 * rp + (wave >> 2); qc = g == 0 ? (fr < 8 ? fr : 48 + fr) : 16 * g - 8 + fr; cs = min(max(qc - 8, 0), 48); ja = g == 0 ? 0 : g - 1; jb = g == 0 ? 3 : g;
        qrowA = (size_t)b * SEQ + rA * 64 + qc; rsA = min(max(rA - 4, 0), 120);
        kr_lo = min(max(2 * rp - 4, 0), 120); const int kr_hi = min(max(2 * rp - 3, 0), 120) + 7; nloc = kr_hi - kr_lo + 1; }
    else qrowA = (size_t)ML + b * CTX + 128 * qhalf + 16 * wave + fr;
    NaQ A;
#pragma unroll
    for (int kk = 0; kk < 4; ++kk) A.qf[kk] = *(const bf16x8*)(P + qrowA * PS + C_NQ + h * 128 + 32 * kk + 8 * fq);
#pragma unroll
    for (int i = 0; i < 8; ++i) A.o[i] = (f32x4){0.f, 0.f, 0.f, 0.f};
    A.m = -1e30f; A.l = 0.f;
    __syncthreads();
    if (loc && tid < 465) bias[tid] = rpb[h * 465 + tid] * 1.4426950408889634f;
    const float scale2 = 0.08838834764831845f * 1.4426950408889634f;
    const int nblk = nloc + 4;
    u32x4 kreg[2], vreg[2];
#define NA_LOAD(blk_) do { const int b_ = (blk_); const size_t kro_ = b_ < nloc ? (size_t)b * SEQ + (kr_lo + b_) * 64 : (size_t)ML + b * CTX + 64 * (b_ - nloc); \
        _Pragma("unroll") for (int i = 0; i < 2; ++i) { const int c = tid + 512 * i, key = c >> 4, part = c & 15; const bf16* src = P + (kro_ + key) * PS + h * 128 + part * 8; \
            kreg[i] = *(const u32x4*)(src + C_NK); vreg[i] = *(const u32x4*)(src + C_NV); } } while (0)
    NA_LOAD(0);
    for (int blk = 0; blk < nblk; ++blk) {
        const bool isl = blk < nloc; const int kr = kr_lo + blk;
        LAS bf16* Ks = (LAS bf16*)(lds + (blk & 1) * 34816); LAS bf16* Vs = Ks + 64 * 136;
#pragma unroll
        for (int i = 0; i < 2; ++i) { const int c = tid + 512 * i, key = c >> 4, part = c & 15;
            *(LAS u32x4*)(Ks + key * 136 + part * 8) = kreg[i]; *(LAS u32x4*)(Vs + key * 136 + part * 8) = vreg[i]; }
        if (blk + 1 < nblk) NA_LOAD(blk + 1);
        __syncthreads();
        if (isl) {
            if (kr >= rsA && kr < rsA + 8) { const LAS float* bpA = bias + ((kr - rA + 7) * 31 - qc + 15);
                na_block<true, true, false>(Ks, Vs, A, A, ja, jb, fr, fq, bpA, bpA, cs, scale2); }
        } else { na_block<false, true, false>(Ks, Vs, A, A, 0, 1, fr, fq, bias, bias, 0, scale2); na_block<false, true, false>(Ks, Vs, A, A, 2, 3, fr, fq, bias, bias, 0, scale2); }
    }
#undef NA_LOAD
    na_store(A, O, qrowA, h, fq);
}

struct GlaPre { float al[4], wl[4], bsv; };
__device__ __forceinline__ void gla_decays_load(GlaPre& g, const Params& p, int l, size_t rowbase, int h, int tid) {
    const float* alpha = (const float*)(p.ws + WS_ALPHA) + rowbase * 32;
#pragma unroll
    for (int j = 0; j < 4; ++j) { const int i = tid + 512 * j; g.al[j] = alpha[i]; const int dir = i >> 10, r = (i >> 6) & 15, d = i & 63; g.wl[j] = (dir ? p.wa_b : p.wa_f)[(size_t)l * 16 * 384 + r * 384 + h * 64 + d]; }
    g.bsv = (((tid >> 6) & 1) ? p.ba_b : p.ba_f)[l * 384 + h * 64 + (tid & 63)];
}
__device__ __forceinline__ void gla_decays(LAS unsigned char* lds, const GlaPre& g, int tid) {
    LAS float* LAF = (LAS float*)lds; LAS float* LAB = (LAS float*)(lds + 16384); LAS float* AL = (LAS float*)(lds + 32768); LAS float* WAL = (LAS float*)(lds + 40960);
    __syncthreads();
#pragma unroll
    for (int j = 0; j < 4; ++j) { AL[tid + 512 * j] = g.al[j]; WAL[tid + 512 * j] = g.wl[j]; }
    __syncthreads();
    {
        const int d = tid & 63, dir = (tid >> 6) & 1, tg = tid >> 7;
        float wa[16];
#pragma unroll
        for (int r = 0; r < 16; ++r) wa[r] = WAL[dir * 1024 + r * 64 + d];
        const float bsv = g.bsv;
        LAS float* LA = dir ? LAB : LAF;
#pragma unroll 4
        for (int i = 0; i < 16; ++i) { const int t = tg * 16 + i; float z = bsv;
#pragma unroll
            for (int r = 0; r < 16; ++r) z += AL[t * 32 + dir * 16 + r] * wa[r];
            const float ls = fminf(z, 0.f) - __builtin_amdgcn_logf(1.f + fast_exp(-fabsf(z))) * 0.6931471805599453f;
            LA[t * 64 + d] = ls * 0.0625f; }
    }
    __syncthreads();
    if (tid < 128) { const int d = tid & 63; const bool fwd = tid < 64; LAS float* LA = fwd ? LAF : LAB; float run = 0.f;
#pragma unroll
        for (int hh = 0; hh < 2; ++hh) { float v[32]; const int t0 = fwd ? 32 * hh : 32 * (1 - hh);
#pragma unroll
            for (int t = 0; t < 32; ++t) v[t] = LA[(t0 + t) * 64 + d];
            if (fwd) {
#pragma unroll
                for (int t = 0; t < 32; ++t) { run += v[t]; v[t] = run; } }
            else {
#pragma unroll
                for (int t = 31; t >= 0; --t) { run += v[t]; v[t] = run; } }
#pragma unroll
            for (int t = 0; t < 32; ++t) LA[(t0 + t) * 64 + d] = v[t]; } }
    __syncthreads();
}
__device__ __forceinline__ void load_rope(u32x2 a, u32x2 c, bool is_lat, const float (&cs)[4], const float (&sn)[4], float (&lo)[4], float (&hi)[4]) {
    float x1[4] = {bflo(a.x), bfhi(a.x), bflo(a.y), bfhi(a.y)}, x2[4] = {bflo(c.x), bfhi(c.x), bflo(c.y), bfhi(c.y)};
#pragma unroll
    for (int e = 0; e < 4; ++e) { if (is_lat) { lo[e] = x1[e] * cs[e] - x2[e] * sn[e]; hi[e] = x1[e] * sn[e] + x2[e] * cs[e]; } else { lo[e] = x1[e]; hi[e] = x2[e]; } }
}
__device__ __forceinline__ void rope_cs(int grow, int s, int i4, float (&cs)[4], float (&sn)[4]) {
#pragma unroll
    for (int e = 0; e < 4; ++e) { const int i = i4 + e; const float inv = __builtin_amdgcn_exp2f(-(float)(i & 15) * 0.8304820237218406f);
        const float ang = (float)(i < 16 ? grow : s) * inv; float f = ang * 0.15915494309189535f; f -= floorf(f);
        sn[e] = __builtin_amdgcn_sinf(f); cs[e] = __builtin_amdgcn_cosf(f); }
}
__device__ __forceinline__ void st4(LAS bf16* dst, float a, float b, float c, float d) { u32x2 w; w.x = pk2(a, b); w.y = pk2(c, d); *(LAS u32x2*)dst = w; }

__device__ __forceinline__ void gla1_item(LAS unsigned char* lds, const Params& p, int l, int b, int h, int ci, int tid, int wave, int lane) {
    const bf16* P = (const bf16*)(p.ws + WS_P);
    const bool is_lat = ci >= 4; const int grow = ci - 4;
    const size_t rowbase = is_lat ? (size_t)b * SEQ + 64 * grow : (size_t)ML + b * CTX + 64 * ci;
    GlaPre gp; gla_decays_load(gp, p, l, rowbase, h, tid);
    const bf16* ksrc = P + (rowbase + (tid >> 3)) * PS + C_GK + h * 64 + (tid & 7) * 4;
    const u32x2 k_a = *(const u32x2*)ksrc, k_c = *(const u32x2*)(ksrc + 32);
    u32x4 vpre[2];
#pragma unroll
    for (int i = 0; i < 2; ++i) { const int c = tid + 512 * i, key = c >> 4, part = c & 15; vpre[i] = *(const u32x4*)(P + (rowbase + key) * PS + C_GV + h * 128 + part * 8); }
    gla_decays(lds, gp, tid);
    LAS float* LAF = (LAS float*)lds; LAS float* LAB = (LAS float*)(lds + 16384);
    LAS bf16* KF = (LAS bf16*)(lds + 49152); LAS bf16* KB = (LAS bf16*)(lds + 58368); LAS bf16* Vs = (LAS bf16*)(lds + 67584);
    {
        const int s = tid >> 3, i4 = (tid & 7) * 4; float cs[4], sn[4], lo[4], hi[4];
        rope_cs(grow, s, i4, cs, sn);
        load_rope(k_a, k_c, is_lat, cs, sn, lo, hi);
        float fl[4], fh[4], bl[4], bh[4];
#pragma unroll
        for (int e = 0; e < 4; ++e) { const int i = i4 + e;
            fl[e] = lo[e] * fast_exp(LAF[63 * 64 + i] - LAF[s * 64 + i]); fh[e] = hi[e] * fast_exp(LAF[63 * 64 + i + 32] - LAF[s * 64 + i + 32]);
            bl[e] = lo[e] * fast_exp(LAB[i] - LAB[s * 64 + i]); bh[e] = hi[e] * fast_exp(LAB[i + 32] - LAB[s * 64 + i + 32]); }
        st4(KF + s * 72 + i4, fl[0], fl[1], fl[2], fl[3]); st4(KF + s * 72 + i4 + 32, fh[0], fh[1], fh[2], fh[3]);
        st4(KB + s * 72 + i4, bl[0], bl[1], bl[2], bl[3]); st4(KB + s * 72 + i4 + 32, bh[0], bh[1], bh[2], bh[3]);
#pragma unroll
        for (int i = 0; i < 2; ++i) { const int c = tid + 512 * i, key = c >> 4, part = c & 15; *(LAS u32x4*)(Vs + key * 136 + part * 8) = vpre[i]; }
    }
    __syncthreads();
    const int fr = lane & 15, fq = lane >> 4, dir = wave >> 2, dkb = wave & 3;
    LAS bf16* UT = (LAS bf16*)(lds + 86016);
    {
        const LAS bf16* Kh = dir ? KB : KF;
        bf16x8 Y[2];
#pragma unroll
        for (int ks = 0; ks < 2; ++ks) { const LAS bf16* a1 = Kh + (32 * ks + 8 * fq + (fr >> 2)) * 72 + 16 * dkb + 4 * (fr & 3); Y[ks] = cat4(tr_read(a1), tr_read(a1 + 4 * 72)); }
#pragma unroll
        for (int dvb = 0; dvb < 8; ++dvb) { f32x4 acc = (f32x4){0.f, 0.f, 0.f, 0.f};
#pragma unroll
            for (int ks = 0; ks < 2; ++ks) { const LAS bf16* x1 = Vs + (32 * ks + 8 * fq + (fr >> 2)) * 136 + 16 * dvb + 4 * (fr & 3); const bf16x8 X = cat4(tr_read(x1), tr_read(x1 + 4 * 136)); acc = MFMA16(Y[ks], X, acc); }
            st4(UT + (dir * 128 + 16 * dvb + fr) * 72 + 16 * dkb + 4 * fq, acc[0], acc[1], acc[2], acc[3]); }
    }
    __syncthreads();
#pragma unroll
    for (int i = 0; i < 4; ++i) { const int c = tid + 512 * i, dd = c >> 10, row = (c >> 3) & 127, part = c & 7;
        const int ch2 = (b * 6 + h) * 2 + dd, ps2 = dd ? (is_lat ? 135 - ci : 3 - ci) : ci;
        *(u32x4*)((bf16*)(p.ws + WS_UBUF) + ((size_t)ch2 * NCH + ps2) * 8192 + row * 64 + part * 8) = *(const LAS u32x4*)(UT + (dd * 128 + row) * 72 + part * 8); }
    if (tid < 128) { const int dd = tid >> 6, d = tid & 63; const int ch2 = (b * 6 + h) * 2 + dd, ps2 = dd ? (is_lat ? 135 - ci : 3 - ci) : ci;
        ((float*)(p.ws + WS_DBUF))[((size_t)ch2 * NCH + ps2) * 64 + d] = fast_exp(dd ? LAB[d] : LAF[63 * 64 + d]); }
}

__device__ __forceinline__ void gla_scan(bf16* U, const float* D, int gtid, int nthr) {
    for (int idx = gtid; idx < 24 * 4096; idx += nthr) {
        const int chain = idx >> 12, e = (idx & 4095) * 2, dk = e & 63;
        unsigned* u = (unsigned*)(U + (size_t)chain * NCH * 8192 + e); const f32x2* d = (const f32x2*)(D + (size_t)chain * NCH * 64 + dk); f32x2 S = (f32x2){0.f, 0.f};
        for (int p0 = 0; p0 < NCH; p0 += 12) {
            unsigned uu[12]; f32x2 dd[12];
#pragma unroll
            for (int i = 0; i < 12; ++i) { uu[i] = u[(size_t)(p0 + i) * 4096]; dd[i] = d[(p0 + i) * 32]; }
#pragma unroll
            for (int i = 0; i < 12; ++i) { u[(size_t)(p0 + i) * 4096] = pk2(S.x, S.y); S.x = dd[i].x * S.x + bflo(uu[i]); S.y = dd[i].y * S.y + bfhi(uu[i]); }
        }
    }
}

__device__ __forceinline__ void gla3_item(LAS unsigned char* lds, const Params& p, int l, int b, int h, int ci, int tid, int wave, int lane) {
    const bf16* P = (const bf16*)(p.ws + WS_P);
    const bool is_lat = ci >= 4; const int grow = ci - 4;
    const size_t rowbase = is_lat ? (size_t)b * SEQ + 64 * grow : (size_t)ML + b * CTX + 64 * ci;
    GlaPre gp; gla_decays_load(gp, p, l, rowbase, h, tid);
    const bf16* ksrc = P + (rowbase + (tid >> 3)) * PS + C_GK + h * 64 + (tid & 7) * 4;
    const u32x2 k_a = *(const u32x2*)ksrc, k_c = *(const u32x2*)(ksrc + 32), q_a = *(const u32x2*)(ksrc + (C_GQ - C_GK)), q_c = *(const u32x2*)(ksrc + (C_GQ - C_GK) + 32);
    u32x4 vpre[2];
#pragma unroll
    for (int i = 0; i < 2; ++i) { const int c = tid + 512 * i, key = c >> 4, part = c & 15; vpre[i] = *(const u32x4*)(P + (rowbase + key) * PS + C_GV + h * 128 + part * 8); }
    u32x4 spre[2][2];
#pragma unroll
    for (int dir = 0; dir < 2; ++dir) { const int chain = (b * 6 + h) * 2 + dir, pos = dir ? (is_lat ? 135 - ci : 3 - ci) : ci;
        const bf16* src = (const bf16*)(p.ws + WS_UBUF) + ((size_t)chain * NCH + pos) * 8192 + (tid >> 2) * 64 + (tid & 3) * 16;
        spre[dir][0] = *(const u32x4*)src; spre[dir][1] = *(const u32x4*)(src + 8); }
    gla_decays(lds, gp, tid);
    LAS float* LAF = (LAS float*)lds; LAS float* LAB = (LAS float*)(lds + 16384);
    LAS bf16* AM = (LAS bf16*)(lds + 32768); LAS bf16* QF = (LAS bf16*)(lds + 49152); LAS bf16* QB = (LAS bf16*)(lds + 58368);
    LAS bf16* KF = (LAS bf16*)(lds + 67584); LAS bf16* KB = (LAS bf16*)(lds + 76800); LAS bf16* Vs = (LAS bf16*)(lds + 86016);
    LAS bf16* SF = (LAS bf16*)(lds + 103424); LAS bf16* SB = (LAS bf16*)(lds + 121856); LAS float* SSQ = (LAS float*)(lds + 140288);
    {
        const int s = tid >> 3, i4 = (tid & 7) * 4; float cs[4], sn[4], klo[4], khi[4], qlo[4], qhi[4];
        rope_cs(grow, s, i4, cs, sn);
        load_rope(k_a, k_c, is_lat, cs, sn, klo, khi);
        load_rope(q_a, q_c, is_lat, cs, sn, qlo, qhi);
        float o1[4], o2[4], o3[4], o4[4];
#pragma unroll
        for (int half = 0; half < 2; ++half) {
#pragma unroll
            for (int e = 0; e < 4; ++e) { const int i = i4 + e + 32 * half; const float bf = LAF[s * 64 + i] - LAF[31 * 64 + i], cb = LAB[s * 64 + i] - LAB[32 * 64 + i];
                const float q = (half ? qhi[e] : qlo[e]) * 0.125f, k = half ? khi[e] : klo[e];
                o1[e] = q * fast_exp(bf); o2[e] = k * fast_exp(-bf); o3[e] = q * fast_exp(cb); o4[e] = k * fast_exp(-cb); }
            st4(QF + s * 72 + i4 + 32 * half, o1[0], o1[1], o1[2], o1[3]); st4(KF + s * 72 + i4 + 32 * half, o2[0], o2[1], o2[2], o2[3]);
            st4(QB + s * 72 + i4 + 32 * half, o3[0], o3[1], o3[2], o3[3]); st4(KB + s * 72 + i4 + 32 * half, o4[0], o4[1], o4[2], o4[3]);
        }
#pragma unroll
        for (int i = 0; i < 2; ++i) { const int c = tid + 512 * i, key = c >> 4, part = c & 15; *(LAS u32x4*)(Vs + key * 136 + part * 8) = vpre[i]; }
        const int dv = tid >> 2, d16 = (tid & 3) * 16;
#pragma unroll
        for (int dir = 0; dir < 2; ++dir) {
            const u32x4 r0 = spre[dir][0], r1 = spre[dir][1];
            f32x4 a0 = (f32x4){bflo(r0.x), bfhi(r0.x), bflo(r0.y), bfhi(r0.y)}, a1 = (f32x4){bflo(r0.z), bfhi(r0.z), bflo(r0.w), bfhi(r0.w)};
            f32x4 a2 = (f32x4){bflo(r1.x), bfhi(r1.x), bflo(r1.y), bfhi(r1.y)}, a3 = (f32x4){bflo(r1.z), bfhi(r1.z), bflo(r1.w), bfhi(r1.w)};
            { const LAS float* mid = dir ? LAB + 32 * 64 + d16 : LAF + 31 * 64 + d16;
#pragma unroll
              for (int j = 0; j < 4; ++j) { a0[j] *= fast_exp(mid[j]); a1[j] *= fast_exp(mid[4 + j]); a2[j] *= fast_exp(mid[8 + j]); a3[j] *= fast_exp(mid[12 + j]); } }
            LAS bf16* dst = (dir ? SB : SF) + dv * 72 + d16;
            u32x4 w0, w1; w0.x = pk2(a0[0], a0[1]); w0.y = pk2(a0[2], a0[3]); w0.z = pk2(a1[0], a1[1]); w0.w = pk2(a1[2], a1[3]);
            w1.x = pk2(a2[0], a2[1]); w1.y = pk2(a2[2], a2[3]); w1.z = pk2(a3[0], a3[1]); w1.w = pk2(a3[2], a3[3]);
            *(LAS u32x4*)dst = w0; *(LAS u32x4*)(dst + 8) = w1; }
    }
    __syncthreads();
    const int fr = lane & 15, fq = lane >> 4, tb = wave & 3, wh = wave >> 2;
#pragma unroll
    for (int q2 = 0; q2 < 2; ++q2) { const int sb = 2 * wh + q2; f32x4 af = (f32x4){0.f, 0.f, 0.f, 0.f}, ab = (f32x4){0.f, 0.f, 0.f, 0.f};
        if (sb <= tb) {
#pragma unroll
            for (int ks = 0; ks < 2; ++ks) { const bf16x8 X = *(const LAS bf16x8*)(KF + (16 * sb + fr) * 72 + 32 * ks + 8 * fq), Y = *(const LAS bf16x8*)(QF + (16 * tb + fr) * 72 + 32 * ks + 8 * fq); af = MFMA16(X, Y, af); } }
        if (sb >= tb) {
#pragma unroll
            for (int ks = 0; ks < 2; ++ks) { const bf16x8 X = *(const LAS bf16x8*)(KB + (16 * sb + fr) * 72 + 32 * ks + 8 * fq), Y = *(const LAS bf16x8*)(QB + (16 * tb + fr) * 72 + 32 * ks + 8 * fq); ab = MFMA16(X, Y, ab); } }
        const int t = 16 * tb + fr; float r[4];
#pragma unroll
        for (int e = 0; e < 4; ++e) { const int s = 16 * sb + 4 * fq + e; r[e] = (s <= t ? af[e] : 0.f) + (s >= t ? ab[e] : 0.f); }
        st4(AM + t * 72 + 16 * sb + 4 * fq, r[0], r[1], r[2], r[3]); }
    __syncthreads();
    bf16x8 Ya[2], Yf[2], Yb[2];
#pragma unroll
    for (int ks = 0; ks < 2; ++ks) { Ya[ks] = *(const LAS bf16x8*)(AM + (16 * tb + fr) * 72 + 32 * ks + 8 * fq); Yf[ks] = *(const LAS bf16x8*)(QF + (16 * tb + fr) * 72 + 32 * ks + 8 * fq); Yb[ks] = *(const LAS bf16x8*)(QB + (16 * tb + fr) * 72 + 32 * ks + 8 * fq); }
    f32x4 acc[4]; float ssq = 0.f;
#pragma unroll
    for (int q = 0; q < 4; ++q) { const int dvb = 4 * wh + q; acc[q] = (f32x4){0.f, 0.f, 0.f, 0.f};
#pragma unroll
        for (int ks = 0; ks < 2; ++ks) { const LAS bf16* x1 = Vs + (32 * ks + 8 * fq + (fr >> 2)) * 136 + 16 * dvb + 4 * (fr & 3); const bf16x8 X = cat4(tr_read(x1), tr_read(x1 + 4 * 136)); acc[q] = MFMA16(X, Ya[ks], acc[q]); }
#pragma unroll
        for (int ks = 0; ks < 2; ++ks) { const bf16x8 X = *(const LAS bf16x8*)(SF + (16 * dvb + fr) * 72 + 32 * ks + 8 * fq); acc[q] = MFMA16(X, Yf[ks], acc[q]); }
#pragma unroll
        for (int ks = 0; ks < 2; ++ks) { const bf16x8 X = *(const LAS bf16x8*)(SB + (16 * dvb + fr) * 72 + 32 * ks + 8 * fq); acc[q] = MFMA16(X, Yb[ks], acc[q]); }
        ssq += (acc[q][0] * acc[q][0] + acc[q][1] * acc[q][1]) + (acc[q][2] * acc[q][2] + acc[q][3] * acc[q][3]); }
    ssq = xrow16_sum(ssq);
    if (fq == 0) SSQ[wh * 64 + 16 * tb + fr] = ssq;
    __syncthreads();
    const float rstd = 1.f / sqrtf((SSQ[16 * tb + fr] + SSQ[64 + 16 * tb + fr]) * (1.f / 128.f) + 1e-6f);
    const size_t row = rowbase + 16 * tb + fr;
    bf16* G = (bf16*)(p.ws + WS_BR);
#pragma unroll
    for (int q = 0; q < 4; ++q) { const int dv0 = 16 * (4 * wh + q) + 4 * fq;
        const f32x4 gn = *(const f32x4*)(p.g_norm + l * 128 + dv0); const u32x2 rr = *(const u32x2*)(P + row * PS + C_GR + h * 128 + dv0);
        const float o0 = acc[q][0] * rstd * gn[0] * siluf_(bflo(rr.x)), o1 = acc[q][1] * rstd * gn[1] * siluf_(bfhi(rr.x)), o2 = acc[q][2] * rstd * gn[2] * siluf_(bflo(rr.y)), o3 = acc[q][3] * rstd * gn[3] * siluf_(bfhi(rr.y));
        u32x2 w; w.x = pk2(o0, o1); w.y = pk2(o2, o3); *(u32x2*)(G + row * DM + 512 + h * 128 + dv0) = w; }
}

#ifndef REP_P0
#define REP_P0 1
#endif
#ifndef REP_N
#define REP_N 1
#endif
#ifndef REP_X1
#define REP_X1 1
#endif
#ifndef REP_X3
#define REP_X3 1
#endif
#ifndef REP_G1
#define REP_G1 1
#endif
#ifndef REP_F1
#define REP_F1 1
#endif
#ifndef REP_M
#define REP_M 1
#endif
#ifndef REP_O1
#define REP_O1 1
#endif
#ifndef REP_F2
#define REP_F2 1
#endif
#ifndef REP_NA
#define REP_NA 1
#endif
#ifndef REP_GL1
#define REP_GL1 1
#endif
#ifndef REP_SYNC
#define REP_SYNC 1
#endif
#define GSYNC() do { for (int r_ = 0; r_ < REP_SYNC; ++r_) xcd_barrier(xbar); } while (0)
typedef const Params __attribute__((address_space(4)))* ParamsCP;
#define PH ParamsCP pp_ = (ParamsCP)__builtin_amdgcn_kernarg_segment_ptr(); asm volatile("" : "+s"(pp_)); Params p; __builtin_memcpy(&p, pp_, sizeof(Params)); \
    int tid_ = threadIdx.x; asm volatile("" : "+v"(tid_)); const int tid = tid_, lane = tid & 63, wave = __builtin_amdgcn_readfirstlane(tid >> 6), gw = bx * 8 + wave; (void)lane; (void)gw; (void)tid; \
    unsigned char* ws = p.ws; float* mada = (float*)(ws + WS_MADA); float* hc = (float*)(ws + WS_HC); bf16* NBUF = (bf16*)(ws + WS_NBUF); bf16* P = (bf16*)(ws + WS_P); \
    bf16* BR = (bf16*)(ws + WS_BR); float* PART = (float*)(ws + WS_UBUF); \
    const bool need_ctx = (l == 0); const float* mv = mada + (size_t)l * 3 * ADA; const float* hL = l == 0 ? p.x : p.out; const float* hC = l == 0 ? p.ctx : hc; const int Mrows = need_ctx ? MT : ML; \
    (void)mada; (void)hc; (void)NBUF; (void)P; (void)BR; (void)PART; (void)mv; (void)hL; (void)hC; (void)Mrows;

__global__ void __launch_bounds__(512, 2) mega_fwd(Params p_unused) {
#if defined(__HIP_DEVICE_COMPILE__)
    extern __shared__ __attribute__((aligned(16))) unsigned char lds_raw[];
    cg::grid_group grid = cg::this_grid();
    LAS unsigned char* lds = (LAS unsigned char*)lds_raw;
    volatile LAS unsigned* MISC = (volatile LAS unsigned*)(lds + LDS_BYTES - 64);
    if (threadIdx.x < 16) MISC[threadIdx.x] = 0u;
    __syncthreads();
    const int G = gridDim.x, bx = blockIdx.x, NGW = G * 8;
    XcdBarrier xbar;
    { const int l = 0; PH xbar = xcd_barrier_post((unsigned*)p.ws, MISC); }

    for (int rep = 0; rep < REP_P0; ++rep) { const int l = 0; PH
        for (int it = bx; it < 192; it += G) adaln_item(p, it, lds, tid, wave, lane);
        __syncthreads();
        convert_weights(p, 0, lds, gw, NGW, wave, lane); }
    if (G == 0x7fffffff) grid.sync();
    GSYNC();

#pragma unroll 1
    for (int l = 0; l < 2; ++l) {
        for (int rep = 0; rep < REP_N; ++rep) { PH
            if (l == 1) convert_weights(p, 1, lds, gw, NGW, wave, lane);
            norm_rows(hL, hC, p.g_mix + l * DM, mv, 1, 0, NBUF, MT, gw, NGW, lane, PART, l == 1 ? 11 : 0, nullptr); }
        GSYNC();

        for (int rep = 0; rep < REP_G1; ++rep) { PH
            pg8::Gemm g{NBUF, (const bf16*)(ws + WS_WIN), MT, NINP, DM}; pg8::StaticOrder S; S.init(MT, NINP, G, bx);
            pg8::EpiInproj E{P, (float*)(ws + WS_ALPHA)};
            pg8::gemm_phase<pg8::EpiInproj, pg8::StaticOrder, true, true>(lds, g, S, E); }
        GSYNC();

        for (int rep = 0; rep < REP_X1; ++rep) { PH
            const int nNA = 768 + (need_ctx ? 24 : 0), nG1 = 2 * 6 * NCH, nCV = Mrows / 64;
            unsigned* qctr = (unsigned*)ws + 3600 + 64 * l;
            for (;;) {
                __syncthreads();
                if (tid == 0) MISC[4] = atomicAdd(qctr, 1u);
                __syncthreads();
                const int it = (int)MISC[4];
                if (it >= nNA + nG1 + nCV) break;
                if (it < nNA) {
                    if (it < 768) na_item(lds, P, p.rpb + (size_t)l * 6 * 465, BR, it / 384, (it >> 6) % 6, it & 63, 0, tid, wave, lane);
                    else { const int j = it - 768; na_item(lds, P, p.rpb, BR, j / 12, (j >> 1) % 6, -1, j & 1, tid, wave, lane); }
                } else if (it < nNA + nG1) { const int j = it - nNA; gla1_item(lds, p, l, j / (6 * NCH), (j / NCH) % 6, j % NCH, tid, wave, lane); }
                else { conv_item(P, p.conv_w + l * 1536, BR, it - nNA - nG1, tid); }
            }
        }
        GSYNC();

        { PH gla_scan((bf16*)(ws + WS_UBUF), (const float*)(ws + WS_DBUF), bx * 512 + tid, G * 512); }
        GSYNC();

        for (int rep = 0; rep < REP_X3; ++rep) { PH
            const int per = need_ctx ? NCH : 128, nG3 = 12 * per;
            for (int it = bx; it < nG3; it += G) { const int bh = it / per, ci = (it % per) + (need_ctx ? 0 : 4); gla3_item(lds, p, l, bh / 6, bh % 6, ci, tid, wave, lane); }
        }
        GSYNC();

        { PH pg8::Gemm g{BR, (const bf16*)(ws + WS_WM), ML, DM, DM}; pg8::LatentOrder S; S.init(G, bx);
          pg8::EpiMerge E{P, NBUF};
          pg8::gemm_phase<pg8::EpiMerge, pg8::LatentOrder, true, true>(lds, g, S, E); }
        if (l == 0) { PH pg8::Gemm g{BR + (size_t)ML * DM, (const bf16*)(ws + WS_WM), MC, DM, DM}; pg8::StaticOrder S; S.init(MC, DM, G, bx);
          pg8::EpiMerge E{P + (size_t)ML * PS, NBUF + (size_t)ML * DM};
          pg8::gemm_phase<pg8::EpiMerge, pg8::StaticOrder, true, true>(lds, g, S, E); }
        GSYNC();

        { PH pg8::Gemm g{NBUF, (const bf16*)(ws + WS_WO), ML, DM, DM}; pg8::LatentOrder S; S.init(G, bx);
          pg8::EpiResid E{hL, p.out, hC, hc, mv + 2 * DM};
          pg8::gemm_phase<pg8::EpiResid, pg8::LatentOrder, true, true>(lds, g, S, E); }
        if (l == 0) { PH pg8::Gemm g{NBUF + (size_t)ML * DM, (const bf16*)(ws + WS_WO), MC, DM, DM, 512}; pg8::SplitKOrder<4, 512> S; S.init(G, bx);
          pg8::EpiPartial E{PART, mv + 2 * ADA + 2 * DM, 512};
          pg8::gemm_phase<pg8::EpiPartial, pg8::SplitKOrder<4, 512>, true, true>(lds, g, S, E); }
        GSYNC();

        for (int rep = 0; rep < REP_N; ++rep) { PH norm_rows(p.out, hC, p.g_ffn + l * DM, mv, 4, 3, NBUF, Mrows, gw, NGW, lane, PART, need_ctx ? 4 : 0, hc); }
        GSYNC();

        for (int rep = 0; rep < REP_F1; ++rep) { PH pg8::Gemm g{NBUF, (const bf16*)(ws + WS_W13), Mrows, 2 * FF, DM}; pg8::StaticOrder S; S.init(Mrows, 2 * FF, G, bx);
          pg8::EpiSwiglu E{P};
          pg8::gemm_phase<pg8::EpiSwiglu, pg8::StaticOrder, true, true>(lds, g, S, E); }
        GSYNC();

        { PH pg8::Gemm g{P, (const bf16*)(ws + WS_W2), ML, DM, FF}; pg8::LatentOrder S; S.init(G, bx);
          pg8::EpiResid E{p.out, p.out, hc, hc, mv + 5 * DM};
          pg8::gemm_phase<pg8::EpiResid, pg8::LatentOrder, true, true>(lds, g, S, E); }
        if (l == 0) { PH pg8::Gemm g{P + (size_t)ML * FF, (const bf16*)(ws + WS_W2), MC, DM, FF, 512}; pg8::SplitKOrder<11, 512> S; S.init(G, bx);
          pg8::EpiPartial E{PART, mv + 2 * ADA + 5 * DM, 512};
          pg8::gemm_phase<pg8::EpiPartial, pg8::SplitKOrder<11, 512>, true, true>(lds, g, S, E); }
        GSYNC();
    }
    { const int l = 1; PH final_norm(p.out, p.g_final, gw, NGW, lane); }
#endif
}

extern "C" void kernel_launch(void* const* d_in, const int* in_sizes, int n_in, void* d_out, int out_size, void* d_ws, size_t ws_size, hipStream_t stream) {
    static int grid = 0;
    if (grid == 0) {
        if (n_in != 24 || out_size != ML * DM || ws_size < WS_END) { fprintf(stderr, "kernel_launch: unexpected shapes (n_in %d out %d ws %zu)\n", n_in, out_size, ws_size); grid = -1; return; }
        int dev = 0, cus = 0, per_cu = 0;
        hipGetDevice(&dev);
        hipDeviceGetAttribute(&cus, hipDeviceAttributeMultiprocessorCount, dev);
        hipFuncSetAttribute((const void*)mega_fwd, hipFuncAttributeMaxDynamicSharedMemorySize, LDS_BYTES);
        if (hipOccupancyMaxActiveBlocksPerMultiprocessor(&per_cu, (const void*)mega_fwd, 512, LDS_BYTES) != hipSuccess || per_cu < 1) { fprintf(stderr, "kernel_launch: occupancy query gave %d\n", per_cu); per_cu = 1; }
        (void)hipGetLastError();
        grid = cus * 1;
    }
    if (grid < 0) return;
    if (hipMemsetAsync(d_ws, 0, 262144, stream) != hipSuccess) { fprintf(stderr, "memset failed\n"); return; }
    Params p{};
    const float** pp = (const float**)&p;
    for (int i = 0; i < 24; ++i) pp[i] = (const float*)d_in[i];
    p.out = (float*)d_out; p.ws = (unsigned char*)d_ws;
    void* args[] = {&p};
    hipError_t e = hipLaunchCooperativeKernel((const void*)mega_fwd, dim3(grid), dim3(512), args, LDS_BYTES, stream);
    if (e != hipSuccess) fprintf(stderr, "cooperative launch failed: %s (grid %d)\n", hipGetErrorString(e), grid);
}
```

```cpp
#include <hip/hip_runtime.h>
#include <hip/hip_cooperative_groups.h>
#include <cstdio>
#include <cstdint>
namespace cg = cooperative_groups;
namespace pg8 {
#define PG8_LAS __attribute__((address_space(3)))
typedef unsigned short bf16_t;
typedef short bf16x8 __attribute__((ext_vector_type(8)));
typedef float f32x4 __attribute__((ext_vector_type(4)));
typedef unsigned u32x4 __attribute__((ext_vector_type(4)));
constexpr int BM = 256, BK = 64, HALF = 128, HTB = HALF * BK * 2  , STAGE_BYTES = 8 * HTB, NXCD = 8, WGM = 4;

__host__ __device__ __forceinline__ int lds_byte(int r, int c) { const int st = (r >> 4) * 2 + (c >> 5), rr = r & 15, cc = c & 31, ob = rr * 64 + cc * 2; return st * 1024 + (ob ^ (((ob >> 9) & 1) << 5)); }
__host__ __device__ __forceinline__ void stage_rc(int b, int& R, int& C) { const int st = b / 1024, sb = b % 1024, swz = sb ^ (((sb >> 9) & 1) << 5); R = (st >> 1) * 16 + swz / 64; C = (st & 1) * 32 + (swz % 64) / 2; }
__host__ __device__ __forceinline__ int perm32(int rho) { const int n = rho >> 4, i = rho & 15; return 8 * (i >> 2) + 4 * n + (i & 3); }

struct Unit { int pm, pn, ko; };
struct Gemm { const bf16_t* A; const bf16_t* Bt; int M, N, K, kloop; };

struct StaticOrder {
    int nM, nN, nwg, G, c;
    __host__ __device__ void init(int M, int N, int G_, int c_) { nM = M / BM; nN = N / BM; nwg = nM * nN; G = G_; c = c_; }
    __host__ __device__ bool next(int i, Unit& u) const {
        const long L = (long)i * G + c; if (L >= nwg) return false;
        int wgid = (int)L; { const int q = nwg / NXCD, r = nwg % NXCD, xcd = wgid % NXCD, off = wgid / NXCD; wgid = (xcd < r ? xcd * (q + 1) : r * (q + 1) + (xcd - r) * q) + off; }
        const int nig = WGM * nN, gid = wgid / nig, fm = gid * WGM, gsz = (nM - fm) < WGM ? (nM - fm) : WGM;
        u.pm = fm + ((wgid % nig) % gsz); u.pn = (wgid % nig) / gsz; u.ko = 0; return true;
    }
    __device__ __forceinline__ void a_ready(const Unit&) const {}
    __device__ __forceinline__ void done(const Unit&) const {}
};
template <int NSPLIT, int KLOOP> struct SplitKOrder {
    int G, c;
    __host__ __device__ void init(int G_, int c_) { G = G_; c = c_; }
    __host__ __device__ bool next(int i, Unit& u) const { const int L = i * G + c; if (L >= 16 * NSPLIT) return false; const int t = L / NSPLIT; u.ko = (L % NSPLIT) * KLOOP; u.pm = t >> 3; u.pn = t & 7; return true; }
    __device__ __forceinline__ void a_ready(const Unit&) const {}
    __device__ __forceinline__ void done(const Unit&) const {}
};
struct LatentOrder {
    StaticOrder so; int c; bool panel;
    __host__ __device__ void init(int G_, int c_) { so.init(16384, 2048, G_, c_); c = c_; panel = (G_ == 256); }
    __host__ __device__ bool next(int i, Unit& u) const {
        if (!panel) return so.next(i, u);
        if (i >= 2) return false; const int x = c & 7, sl = c >> 3; u.pm = i * 32 + x * 4 + (sl >> 3); u.pn = sl & 7; u.ko = 0; return true; }
    __device__ __forceinline__ void a_ready(const Unit&) const {}
    __device__ __forceinline__ void done(const Unit&) const {}
};
__device__ __forceinline__ unsigned cvt_pk_bf16(float lo, float hi) { unsigned r; asm volatile("v_cvt_pk_bf16_f32 %0, %1, %2" : "=v"(r) : "v"(lo), "v"(hi)); return r; }
template <class Epi, class Sched, bool ALIGN_EPI = false, bool SP2 = false>
__device__ __forceinline__ void gemm_phase(PG8_LAS unsigned char* lds, const Gemm g, const Sched& S, const Epi& E) {
    int tid_ = threadIdx.x; asm volatile("" : "+v"(tid_)); const int tid = tid_, wid = __builtin_amdgcn_readfirstlane(tid >> 6), lane = tid & 63, wr = wid >> 2, wc = wid & 3, fr = lane & 15, fq = lane >> 4;
    const int K = g.K; int nt_ = (g.kloop ? g.kloop : K) / BK; asm volatile("" : "+s"(nt_)); const int nt = nt_;
    unsigned voffA[2], voffB[2];
#pragma unroll
    for (int i = 0; i < 2; ++i) { int R, C; stage_rc(tid * 16 + i * 8192, R, C); const int Rb = Epi::PERM ? ((R & ~31) + perm32(R & 31)) : R;
        voffA[i] = (unsigned)(R * K + C) * 2u; voffB[i] = (unsigned)(Rb * K + C) * 2u; }
    const size_t kstep = (size_t)(BK * 2);
    const size_t hstep = (size_t)HALF * K * 2;
    const size_t tstep = 2 * hstep;
    const unsigned ldsw = (unsigned)wid * 1024u;
    const int aoff = lds_byte(wr * 64 + fr, fq * 8), boff = lds_byte(wc * 32 + fr, fq * 8);
#define PG8_SA(b, h) (((b) * 2 + (h)) * HTB)
#define PG8_SB(b, h) ((4 + (b) * 2 + (h)) * HTB)
#define PG8_STAGE(bufoff, gbase, voff) do { _Pragma("unroll") for (int _i = 0; _i < 2; ++_i) \
        __builtin_amdgcn_global_load_lds((const unsigned*)((const char*)(gbase) + (voff)[_i]), (PG8_LAS unsigned*)(lds + (bufoff) + ldsw + _i * 8192), 16, 0, 0); } while (0)
#define PG8_LDA(dst, b, h) do { _Pragma("unroll") for (int m = 0; m < 4; ++m) _Pragma("unroll") for (int k = 0; k < 2; ++k) dst[m][k] = *(const PG8_LAS bf16x8*)(lds + PG8_SA(b, h) + aoff + m * 2048 + k * 1024); } while (0)
#define PG8_LDB(dst, b, h) do { _Pragma("unroll") for (int n = 0; n < 2; ++n) _Pragma("unroll") for (int k = 0; k < 2; ++k) dst[n][k] = *(const PG8_LAS bf16x8*)(lds + PG8_SB(b, h) + boff + n * 2048 + k * 1024); } while (0)
#define PG8_MMA(ai, bj, At, Bt) do { __builtin_amdgcn_s_setprio(1); _Pragma("unroll") for (int m = 0; m < 4; ++m) _Pragma("unroll") for (int n = 0; n < 2; ++n) _Pragma("unroll") for (int k = 0; k < 2; ++k) \
        acc[ai][bj][m][n] = __builtin_amdgcn_mfma_f32_16x16x32_bf16(Bt[n][k], At[m][k], acc[ai][bj][m][n], 0, 0, 0); __builtin_amdgcn_s_setprio(0); } while (0)
#define PG8_WAIT_V(n) asm volatile("s_waitcnt vmcnt(" #n ")" ::: "memory")
#define PG8_WAIT_L(n) asm volatile("s_waitcnt lgkmcnt(" #n ")" ::: "memory")
#define PG8_BAR __builtin_amdgcn_s_barrier()
#define PG8_SCHED __builtin_amdgcn_sched_barrier(0)
    Unit cur, nxt; int ui = 0;
    if (!S.next(0, cur)) return;
    f32x4 acc[2][2][4][2];
#pragma unroll
    for (int a = 0; a < 2; ++a)
#pragma unroll
        for (int b = 0; b < 2; ++b)
#pragma unroll
            for (int m = 0; m < 4; ++m)
#pragma unroll
                for (int n = 0; n < 2; ++n) acc[a][b][m][n] = (f32x4){0.f, 0.f, 0.f, 0.f};
    bf16x8 At[4][2], B0[2][2], B1[2][2];
    const char* cA = (const char*)g.A + (size_t)cur.pm * tstep + (size_t)cur.ko * 2; const char* cB = (const char*)g.Bt + (size_t)cur.pn * tstep + (size_t)cur.ko * 2;
    S.a_ready(cur);
    if constexpr (SP2) {
        PG8_STAGE(PG8_SB(0, 0), cB, voffB); PG8_STAGE(PG8_SB(0, 1), cB + hstep, voffB); PG8_STAGE(PG8_SA(0, 0), cA, voffA); PG8_STAGE(PG8_SA(0, 1), cA + hstep, voffA);
        if (wr == 1) PG8_BAR;
        PG8_WAIT_V(2); PG8_BAR;
        PG8_STAGE(PG8_SB(1, 0), cB + kstep, voffB); PG8_STAGE(PG8_SA(1, 0), cA + kstep, voffA); PG8_STAGE(PG8_SB(1, 1), cB + hstep + kstep, voffB);
        PG8_WAIT_V(6); PG8_BAR;
    } else {
        PG8_STAGE(PG8_SB(0, 0), cB, voffB); PG8_STAGE(PG8_SA(0, 0), cA, voffA); PG8_STAGE(PG8_SB(0, 1), cB + hstep, voffB); PG8_STAGE(PG8_SA(0, 1), cA + hstep, voffA);
        if (wr == 1) PG8_BAR;
        PG8_WAIT_V(4); PG8_BAR;
        PG8_STAGE(PG8_SB(1, 0), cB + kstep, voffB); PG8_STAGE(PG8_SA(1, 0), cA + kstep, voffA); PG8_STAGE(PG8_SB(1, 1), cB + hstep + kstep, voffB);
        PG8_WAIT_V(6); PG8_BAR;
    }
    for (;;) {
        const bool has_next = S.next(ui + 1, nxt);
        const char* nA = has_next ? (const char*)g.A + (size_t)nxt.pm * tstep + (size_t)nxt.ko * 2 : cA; const char* nB = has_next ? (const char*)g.Bt + (size_t)nxt.pn * tstep + (size_t)nxt.ko * 2 : cB;
        for (int t = 0; t < nt; t += 2) {
            if constexpr (Epi::MIDHOOK) { if (t == 8 || t == 20) E.mid(acc, cur, wr, wc, fr, fq, t); }
            const bool last = (t == nt - 2);
            const char* a1 = cA + (size_t)(t + 1) * kstep;
            const char* a2 = last ? nA : cA + (size_t)(t + 2) * kstep; const char* b2 = last ? nB : cB + (size_t)(t + 2) * kstep;
            const char* a3 = a2 + kstep; const char* b3 = b2 + kstep;
            if (last && has_next) S.a_ready(nxt);
            if constexpr (SP2) {
            PG8_LDB(B0, 0, 0); PG8_LDB(B1, 0, 1); PG8_SCHED; PG8_LDA(At, 0, 0); PG8_STAGE(PG8_SA(1, 1), a1 + hstep, voffA);
            PG8_WAIT_V(8); PG8_WAIT_L(0); PG8_BAR; PG8_MMA(0, 0, At, B0); PG8_MMA(0, 1, At, B1); PG8_BAR; PG8_SCHED;
            PG8_LDA(At, 0, 1); PG8_STAGE(PG8_SB(0, 0), b2, voffB); PG8_STAGE(PG8_SB(0, 1), b2 + hstep, voffB); PG8_STAGE(PG8_SA(0, 0), a2, voffA);
            PG8_WAIT_V(8); PG8_WAIT_L(0); PG8_BAR; PG8_MMA(1, 0, At, B0); PG8_MMA(1, 1, At, B1); PG8_BAR; PG8_SCHED;
            PG8_LDB(B0, 1, 0); PG8_LDB(B1, 1, 1); PG8_SCHED; PG8_LDA(At, 1, 0); PG8_STAGE(PG8_SA(0, 1), a2 + hstep, voffA);
            PG8_WAIT_V(8); PG8_WAIT_L(0); PG8_BAR; PG8_MMA(0, 0, At, B0); PG8_MMA(0, 1, At, B1); PG8_BAR; PG8_SCHED;
            PG8_LDA(At, 1, 1); PG8_STAGE(PG8_SB(1, 0), b3, voffB); PG8_STAGE(PG8_SB(1, 1), b3 + hstep, voffB); PG8_STAGE(PG8_SA(1, 0), a3, voffA);
            PG8_WAIT_V(8); PG8_WAIT_L(0); PG8_BAR; PG8_MMA(1, 0, At, B0); PG8_MMA(1, 1, At, B1); PG8_BAR; PG8_SCHED;
            } else {
            PG8_LDB(B0, 0, 0); PG8_SCHED; PG8_LDA(At, 0, 0); PG8_STAGE(PG8_SA(1, 1), a1 + hstep, voffA);
            PG8_WAIT_L(8); PG8_BAR; PG8_WAIT_L(0); PG8_MMA(0, 0, At, B0); PG8_BAR; PG8_SCHED;
            PG8_LDB(B1, 0, 1); PG8_STAGE(PG8_SB(0, 0), b2, voffB);
            PG8_BAR; PG8_WAIT_L(0); PG8_MMA(0, 1, At, B1); PG8_BAR;
            PG8_LDA(At, 0, 1); PG8_STAGE(PG8_SA(0, 0), a2, voffA);
            PG8_BAR; PG8_WAIT_L(0); PG8_MMA(1, 0, At, B0); PG8_BAR; PG8_SCHED;
            PG8_STAGE(PG8_SB(0, 1), b2 + hstep, voffB);
            PG8_WAIT_V(6); PG8_BAR; PG8_MMA(1, 1, At, B1); PG8_BAR;
            PG8_LDB(B0, 1, 0); PG8_SCHED; PG8_LDA(At, 1, 0); PG8_STAGE(PG8_SA(0, 1), a2 + hstep, voffA);
            PG8_WAIT_L(8); PG8_BAR; PG8_WAIT_L(0); PG8_MMA(0, 0, At, B0); PG8_BAR; PG8_SCHED;
            PG8_LDB(B1, 1, 1); PG8_STAGE(PG8_SB(1, 0), b3, voffB);
            PG8_BAR; PG8_WAIT_L(0); PG8_MMA(0, 1, At, B1); PG8_BAR;
            PG8_LDA(At, 1, 1); PG8_STAGE(PG8_SA(1, 0), a3, voffA);
            PG8_BAR; PG8_WAIT_L(0); PG8_MMA(1, 0, At, B0); PG8_BAR; PG8_SCHED;
            PG8_STAGE(PG8_SB(1, 1), b3 + hstep, voffB);
            PG8_WAIT_V(6); PG8_BAR; PG8_MMA(1, 1, At, B1); PG8_BAR;
            }
        }
        if constexpr (ALIGN_EPI) { if (wr == 0) PG8_BAR; }
        if constexpr (!Epi::AFTER_DRAIN) { E(acc, cur, wr, wc, fr, fq); S.done(cur); }
        if (!has_next) break;
#pragma unroll
        for (int a = 0; a < 2; ++a)
#pragma unroll
            for (int b = 0; b < 2; ++b)
#pragma unroll
                for (int m = 0; m < 4; ++m)
#pragma unroll
                    for (int n = 0; n < 2; ++n) acc[a][b][m][n] = (f32x4){0.f, 0.f, 0.f, 0.f};
        cur = nxt; cA = nA; cB = nB; ++ui;
        if constexpr (ALIGN_EPI) { if (wr == 1) PG8_BAR; }
    }
    PG8_WAIT_V(0);
    if constexpr (!ALIGN_EPI) { if (wr == 0) PG8_BAR; }
    PG8_BAR;
    if constexpr (Epi::AFTER_DRAIN) { E.fused(acc, cur, wr, wc, fr, fq, lds, wid, lane); S.done(cur); }
#undef PG8_SA
#undef PG8_SB
#undef PG8_STAGE
#undef PG8_LDA
#undef PG8_LDB
#undef PG8_MMA
#undef PG8_WAIT_V
#undef PG8_WAIT_L
#undef PG8_BAR
#undef PG8_SCHED
}
}

#define LAS __attribute__((address_space(3)))
typedef unsigned short bf16;
typedef short bf16x8 __attribute__((ext_vector_type(8)));
typedef short s16x4 __attribute__((ext_vector_type(4)));
typedef float f32x4 __attribute__((ext_vector_type(4)));
typedef float f32x2 __attribute__((ext_vector_type(2)));
typedef unsigned u32x4 __attribute__((ext_vector_type(4)));
typedef unsigned u32x2 __attribute__((ext_vector_type(2)));

constexpr int DM = 2048, SEQ = 8192, NB = 2, CTX = 256;
constexpr int ML = NB * SEQ;
constexpr int MC = NB * CTX;
constexpr int MT = ML + MC;
constexpr int INC = 12320;
constexpr int PS = 12288;
constexpr int NINP = 12544;
constexpr int FF = 5632;
constexpr int ADA = 6 * DM;
constexpr int C_AIN = 0, C_AB = 512, C_AC = 1024, C_GQ = 1536, C_GK = 1920, C_GV = 2304, C_GR = 3072, C_NQ = 3840, C_NK = 4608, C_NV = 5376, C_GATE = 6144;
constexpr int NCH = 132;

constexpr size_t MiB = 1u << 20;
constexpr size_t WS_MADA = 1 * MiB, WS_HC = 2 * MiB, WS_ALPHA = 6 * MiB, WS_DBUF = 9 * MiB, WS_NBUF = 10 * MiB;
constexpr size_t WS_BR = 76 * MiB;
constexpr size_t WS_P = 142 * MiB, WS_UBUF = 538 * MiB;
constexpr size_t WS_WIN = 637 * MiB, WS_W13 = 686 * MiB, WS_W2 = 730 * MiB, WS_WO = 752 * MiB, WS_WM = 760 * MiB, WS_END = 768 * MiB;
static_assert(WS_BR + (size_t)MT * DM * 2 <= WS_P, "ws map");
static_assert(WS_P + (size_t)MT * PS * 2 <= WS_UBUF, "ws map");
static_assert(WS_UBUF + (size_t)24 * NCH * 8192 * 4 <= WS_WIN, "ws map");

constexpr int LDS_BYTES = 147456;

struct Params {
    const float *x, *c, *ctx, *c_ctx, *w_ada, *b_ada, *g_mix, *g_ffn, *w_in, *conv_w, *wa_f, *ba_f, *wa_b, *ba_b, *g_norm, *rpb,
                *w_a_out, *w_g_out, *w_n_out, *w_o, *w1, *w3, *w2, *g_final;
    float* out; unsigned char* ws;
};

__device__ __forceinline__ float bf2f(unsigned short v) { return __builtin_bit_cast(float, (unsigned)v << 16); }
__device__ __forceinline__ float bflo(unsigned v) { return __builtin_bit_cast(float, v << 16); }
__device__ __forceinline__ float bfhi(unsigned v) { return __builtin_bit_cast(float, v & 0xffff0000u); }
__device__ __forceinline__ unsigned f2bf(float f) { unsigned u = __builtin_bit_cast(unsigned, f); return (u + 0x7fffu + ((u >> 16) & 1u)) >> 16; }
typedef __bf16 bf16x2_t __attribute__((ext_vector_type(2)));
__device__ __forceinline__ unsigned pk2(float lo, float hi) { f32x2 v = {lo, hi}; bf16x2_t b = __builtin_convertvector(v, bf16x2_t); return __builtin_bit_cast(unsigned, b); }
__device__ __forceinline__ float fast_exp(float x) { return __builtin_amdgcn_exp2f(x * 1.4426950408889634f); }
__device__ __forceinline__ float fast_rcp(float x) { return __builtin_amdgcn_rcpf(x); }
__device__ __forceinline__ float sigmoidf_(float x) { return fast_rcp(1.f + fast_exp(-x)); }
__device__ __forceinline__ float siluf_(float x) { return x * sigmoidf_(x); }
__device__ __forceinline__ float wave_sum(float v) {
#pragma unroll
    for (int o = 1; o < 64; o <<= 1) v += __shfl_xor(v, o);
    return v;
}
__device__ __forceinline__ float xrow16_max(float x) {
    auto s = __builtin_amdgcn_permlane16_swap(__float_as_uint(x), __float_as_uint(x), false, false);
    x = fmaxf(__uint_as_float(s[0]), __uint_as_float(s[1]));
    auto t = __builtin_amdgcn_permlane32_swap(__float_as_uint(x), __float_as_uint(x), false, false);
    return fmaxf(__uint_as_float(t[0]), __uint_as_float(t[1]));
}
__device__ __forceinline__ float xrow16_sum(float x) {
    auto s = __builtin_amdgcn_permlane16_swap(__float_as_uint(x), __float_as_uint(x), false, false);
    x = __uint_as_float(s[0]) + __uint_as_float(s[1]);
    auto t = __builtin_amdgcn_permlane32_swap(__float_as_uint(x), __float_as_uint(x), false, false);
    return __uint_as_float(t[0]) + __uint_as_float(t[1]);
}
__device__ __forceinline__ s16x4 tr_read(const LAS bf16* p) {
    typedef short v4i16_t __attribute__((ext_vector_type(4)));
    return __builtin_bit_cast(s16x4, __builtin_amdgcn_ds_read_tr16_b64_v4i16((LAS v4i16_t*)p));
}
__device__ __forceinline__ bf16x8 cat4(s16x4 a, s16x4 b) { return (bf16x8){a[0], a[1], a[2], a[3], b[0], b[1], b[2], b[3]}; }
#define MFMA16(X, Y, C) __builtin_amdgcn_mfma_f32_16x16x32_bf16((X), (Y), (C), 0, 0, 0)

namespace pg8 {
struct EpiInproj {
    static constexpr bool PERM = true, AFTER_DRAIN = false, MIDHOOK = false;
    bf16_t* P; float* alpha;
    __device__ __forceinline__ void operator()(const f32x4 (&acc)[2][2][4][2], const Unit& u, int wr, int wc, int fr, int fq) const {
        const int row0 = u.pm * 256 + wr * 64 + fr;
        if (u.pn < 48) {
            const bool sg = u.pn >= 24;
            const int col0 = u.pn * 256 + wc * 32 + 8 * fq;
#pragma unroll
            for (int ai = 0; ai < 2; ++ai)
#pragma unroll
                for (int m = 0; m < 4; ++m) {
                    bf16_t* rowp = P + (size_t)(row0 + ai * 128 + m * 16) * PS + col0;
#pragma unroll
                    for (int bj = 0; bj < 2; ++bj) {
                        f32x4 v0 = acc[ai][bj][m][0], v1 = acc[ai][bj][m][1];
                        if (sg) {
#pragma unroll
                            for (int e = 0; e < 4; ++e) { v0[e] = sigmoidf_(v0[e]); v1[e] = sigmoidf_(v1[e]); }
                        }
                        u32x4 w; w.x = pk2(v0[0], v0[1]); w.y = pk2(v0[2], v0[3]); w.z = pk2(v1[0], v1[1]); w.w = pk2(v1[2], v1[3]);
                        *(u32x4*)(rowp + bj * 128) = w;
                    }
                }
        } else if (wc == 0) {
#pragma unroll
            for (int ai = 0; ai < 2; ++ai)
#pragma unroll
                for (int m = 0; m < 4; ++m) {
                    float* ap = alpha + (size_t)(row0 + ai * 128 + m * 16) * 32 + 8 * fq;
                    *(f32x4*)ap = acc[ai][0][m][0]; *(f32x4*)(ap + 4) = acc[ai][0][m][1];
                }
        }
    }
};

struct EpiMerge {
    static constexpr bool PERM = true, AFTER_DRAIN = false, MIDHOOK = true;
    const bf16_t* P; bf16_t* Yb;
    __device__ __forceinline__ void mid(f32x4 (&acc)[2][2][4][2], const Unit& u, int wr, int wc, int fr, int fq, int t) const {
        int fr_ = fr; asm volatile("" : "+v"(fr_));
        const int row0 = u.pm * 256 + wr * 64 + fr_, col0 = u.pn * 256 + wc * 32 + 8 * fq, noff = C_GATE + (t == 8 ? 0 : 2048);
#pragma unroll
        for (int ai = 0; ai < 2; ++ai)
#pragma unroll
            for (int m = 0; m < 4; ++m) {
                const bf16_t* gp = P + (size_t)(row0 + ai * 128 + m * 16) * PS + noff + col0;
#pragma unroll
                for (int bj = 0; bj < 2; ++bj) {
                    const u32x4 gn = *(const u32x4*)(gp + bj * 128), gd = *(const u32x4*)(gp + bj * 128 + 2048);
                    f32x4 r0, r1;
                    r0[0] = bflo(gn.x) * fast_rcp(fmaxf(bflo(gd.x), 1e-20f)); r0[1] = bfhi(gn.x) * fast_rcp(fmaxf(bfhi(gd.x), 1e-20f));
                    r0[2] = bflo(gn.y) * fast_rcp(fmaxf(bflo(gd.y), 1e-20f)); r0[3] = bfhi(gn.y) * fast_rcp(fmaxf(bfhi(gd.y), 1e-20f));
                    r1[0] = bflo(gn.z) * fast_rcp(fmaxf(bflo(gd.z), 1e-20f)); r1[1] = bfhi(gn.z) * fast_rcp(fmaxf(bfhi(gd.z), 1e-20f));
                    r1[2] = bflo(gn.w) * fast_rcp(fmaxf(bflo(gd.w), 1e-20f)); r1[3] = bfhi(gn.w) * fast_rcp(fmaxf(bfhi(gd.w), 1e-20f));
                    acc[ai][bj][m][0] *= r0; acc[ai][bj][m][1] *= r1;
                }
                if (m == 1 || m == 3) __builtin_amdgcn_sched_barrier(0);
            }
    }
    __device__ __forceinline__ void operator()(const f32x4 (&acc)[2][2][4][2], const Unit& u, int wr, int wc, int fr, int fq) const {
        const int row0 = u.pm * 256 + wr * 64 + fr, col0 = u.pn * 256 + wc * 32 + 8 * fq;
#pragma unroll
        for (int ai = 0; ai < 2; ++ai)
#pragma unroll
            for (int m = 0; m < 4; ++m) {
                const size_t row = (size_t)(row0 + ai * 128 + m * 16);
#pragma unroll
                for (int bj = 0; bj < 2; ++bj) {
                    const int col = col0 + bj * 128;
                    const u32x4 g = *(const u32x4*)(P + row * PS + C_GATE + 4096 + col);
                    f32x4 v0 = acc[ai][bj][m][0], v1 = acc[ai][bj][m][1];
                    v0[0] *= fmaxf(bflo(g.x), 1e-20f); v0[1] *= fmaxf(bfhi(g.x), 1e-20f); v0[2] *= fmaxf(bflo(g.y), 1e-20f); v0[3] *= fmaxf(bfhi(g.y), 1e-20f);
                    v1[0] *= fmaxf(bflo(g.z), 1e-20f); v1[1] *= fmaxf(bfhi(g.z), 1e-20f); v1[2] *= fmaxf(bflo(g.w), 1e-20f); v1[3] *= fmaxf(bfhi(g.w), 1e-20f);
                    u32x4 w; w.x = pk2(v0[0], v0[1]); w.y = pk2(v0[2], v0[3]); w.z = pk2(v1[0], v1[1]); w.w = pk2(v1[2], v1[3]);
                    *(u32x4*)(Yb + row * DM + col) = w;
                }
            }
    }
};

struct EpiResid {
    static constexpr bool PERM = true, AFTER_DRAIN = false, MIDHOOK = false;
    const float* srcL; float* dstL; const float* srcC; float* dstC; const float* gate;
    __device__ __forceinline__ void operator()(const f32x4 (&acc)[2][2][4][2], const Unit& u, int wr, int wc, int fr, int fq) const {
        const bool isc = u.pm >= 64;
        const int row0 = (isc ? (u.pm - 64) * 256 : u.pm * 256) + wr * 64 + fr, col0 = u.pn * 256 + wc * 32 + 8 * fq;
        const float* src = isc ? srcC : srcL; float* dst = isc ? dstC : dstL;
        const float* gv = gate + (isc ? 2 : (u.pm >> 5)) * ADA;
#pragma unroll
        for (int bj = 0; bj < 2; ++bj) {
            const int col = col0 + bj * 128;
            const f32x4 g0 = *(const f32x4*)(gv + col), g1 = *(const f32x4*)(gv + col + 4);
#pragma unroll
            for (int ai = 0; ai < 2; ++ai)
#pragma unroll
                for (int m = 0; m < 4; ++m) {
                    const size_t off = (size_t)(row0 + ai * 128 + m * 16) * DM + col;
                    const f32x4 s0 = *(const f32x4*)(src + off), s1 = *(const f32x4*)(src + off + 4);
                    *(f32x4*)(dst + off) = s0 + g0 * acc[ai][bj][m][0];
                    *(f32x4*)(dst + off + 4) = s1 + g1 * acc[ai][bj][m][1];
                }
        }
    }
};

struct EpiSwiglu {
    static constexpr bool PERM = true, AFTER_DRAIN = false, MIDHOOK = false;
    bf16_t* H;
    __device__ __forceinline__ void operator()(const f32x4 (&acc)[2][2][4][2], const Unit& u, int wr, int wc, int fr, int fq) const {
        const int row0 = u.pm * 256 + wr * 64 + fr, col0 = u.pn * 128 + wc * 32 + 8 * fq;
#pragma unroll
        for (int ai = 0; ai < 2; ++ai)
#pragma unroll
            for (int m = 0; m < 4; ++m) {
                f32x4 v0 = acc[ai][0][m][0], v1 = acc[ai][0][m][1];
                const f32x4 t0 = acc[ai][1][m][0], t1 = acc[ai][1][m][1];
#pragma unroll
                for (int e = 0; e < 4; ++e) { v0[e] = siluf_(v0[e]) * t0[e]; v1[e] = siluf_(v1[e]) * t1[e]; }
                u32x4 w; w.x = pk2(v0[0], v0[1]); w.y = pk2(v0[2], v0[3]); w.z = pk2(v1[0], v1[1]); w.w = pk2(v1[2], v1[3]);
                *(u32x4*)(H + (size_t)(row0 + ai * 128 + m * 16) * FF + col0) = w;
            }
    }
};

struct EpiPartial {
    static constexpr bool PERM = true, AFTER_DRAIN = false, MIDHOOK = false;
    float* part; const float* gv; int kloop;
    __device__ __forceinline__ void operator()(const f32x4 (&acc)[2][2][4][2], const Unit& u, int wr, int wc, int fr, int fq) const {
        const int row0 = u.pm * 256 + wr * 64 + fr, col0 = u.pn * 256 + wc * 32 + 8 * fq;
        float* dst = part + (size_t)(u.ko / kloop) * MC * DM;
#pragma unroll
        for (int bj = 0; bj < 2; ++bj) {
            const int col = col0 + bj * 128;
            const f32x4 g0 = *(const f32x4*)(gv + col), g1 = *(const f32x4*)(gv + col + 4);
#pragma unroll
            for (int ai = 0; ai < 2; ++ai)
#pragma unroll
                for (int m = 0; m < 4; ++m) {
                    const size_t off = (size_t)(row0 + ai * 128 + m * 16) * DM + col;
                    *(f32x4*)(dst + off) = g0 * acc[ai][bj][m][0];
                    *(f32x4*)(dst + off + 4) = g1 * acc[ai][bj][m][1];
                }
        }
    }
};
}
#define XB_TMO      128
#define XB_XCNT(j)  (256  + 64 * (j))
#define XB_XSUB(j)  (1280 + 64 * (j))
#define XB_XGEN(j)  (2304 + 64 * (j))
#define XB_TOP      3328
#define XB_TOPGEN   3392
#define XCD_BAR_WORDS 3456
#define XB_SPIN_CAP (1u << 18)

__device__ __forceinline__ unsigned xb_ld(unsigned* p)              { return __hip_atomic_load(p, __ATOMIC_RELAXED, __HIP_MEMORY_SCOPE_AGENT); }
__device__ __forceinline__ unsigned xb_add(unsigned* p, unsigned v) { return __hip_atomic_fetch_add(p, v, __ATOMIC_RELAXED, __HIP_MEMORY_SCOPE_AGENT); }
__device__ __forceinline__ unsigned xb_xcc_id() { return (unsigned)__builtin_amdgcn_s_getreg((3 << 11) | 20) & 0xFu; }
#define XB_SPIN(cond, bar) do { unsigned _sp = 0; while (cond) { __builtin_amdgcn_s_sleep(1); \
    if ((++_sp & 255u) == 0u) { if (xb_ld(&(bar)[XB_TMO])) break; if (_sp > XB_SPIN_CAP) { atomicAdd(&(bar)[XB_TMO], 1u); break; } } } } while (0)

struct XcdBarrier {
    unsigned* bar; unsigned x;
    volatile LAS unsigned* st;
};

__device__ __forceinline__ XcdBarrier xcd_barrier_post(unsigned* bar, volatile LAS unsigned* st) {
    XcdBarrier b; b.bar = bar; b.x = xb_xcc_id(); b.st = st;
    if (threadIdx.x == 0) (void)xb_add(&bar[XB_XCNT(b.x)], 1u);
    return b;
}
__device__ __forceinline__ void xcd_barrier_complete(unsigned* bar, unsigned x, unsigned& nloc, unsigned& nx) {
    const unsigned G = gridDim.x * gridDim.y * gridDim.z;
    unsigned sum, cnt, mine, sp = 0u;
    for (;;) {
        sum = 0u; cnt = 0u; mine = 0u;
#pragma unroll
        for (unsigned j = 0; j < 16; ++j) { const unsigned c = xb_ld(&bar[XB_XCNT(j)]); sum += c; cnt += (c > 0u) ? 1u : 0u; mine = (j == x) ? c : mine; }
        if (sum == G) break;
        __builtin_amdgcn_s_sleep(1);
        if ((++sp & 255u) == 0u) { if (xb_ld(&bar[XB_TMO])) break; if (sp > XB_SPIN_CAP) { atomicAdd(&bar[XB_TMO], 1u); break; } }
    }
    nloc = mine > 0u ? mine : 1u; nx = cnt > 0u ? cnt : 1u;
}

__device__ __forceinline__ void xcd_barrier(const XcdBarrier& b) {
    asm volatile("s_waitcnt vmcnt(0)" ::: "memory");
    __syncthreads();
    if (threadIdx.x == 0) {
        unsigned* bar = b.bar;
        __builtin_amdgcn_s_waitcnt(0);
        unsigned nloc = b.st[0], nx = b.st[1];
        if (nloc == 0u) { xcd_barrier_complete(bar, b.x, nloc, nx); b.st[0] = nloc; b.st[1] = nx; }
        const unsigned old = xb_add(&bar[XB_XSUB(b.x)], 1u);
        const unsigned gen = old / nloc;
        if (old + 1u == (gen + 1u) * nloc) {
            __builtin_amdgcn_fence(__ATOMIC_RELEASE, "agent");
            asm volatile("s_waitcnt vmcnt(0)" ::: "memory");
            const unsigned og = xb_add(&bar[XB_TOP], 1u);
            const unsigned tg = og / nx;
            if (og + 1u == (tg + 1u) * nx) xb_add(&bar[XB_TOPGEN], 1u);
            else XB_SPIN(xb_ld(&bar[XB_TOPGEN]) == tg, bar);
            __builtin_amdgcn_fence(__ATOMIC_ACQUIRE, "agent");
            xb_add(&bar[XB_XGEN(b.x)], 1u);
            asm volatile("s_waitcnt vmcnt(0)" ::: "memory");
        } else {
            XB_SPIN(xb_ld(&bar[XB_XGEN(b.x)]) == gen, bar);
            __builtin_amdgcn_fence(__ATOMIC_ACQUIRE, "agent");
            asm volatile("s_waitcnt vmcnt(0)" ::: "memory");
        }
    }
    __syncthreads();
}

__device__ __forceinline__ void transpose_item(const float* W, int K, int Nsrc, int src_n0, bf16* WT, int dst_n0, int k0, LAS float* scr, int lane, int dpitch = 0, int dk0 = 0) {
    if (!dpitch) dpitch = K;
    if (W) {
#pragma unroll 8
        for (int i = 0; i < 32; ++i) { const int kk = 2 * i + (lane >> 5); scr[kk * 33 + (lane & 31)] = W[(size_t)(k0 + kk) * Nsrc + src_n0 + (lane & 31)]; }
    } else {
#pragma unroll 8
        for (int i = 0; i < 32; ++i) { const int kk = 2 * i + (lane >> 5); scr[kk * 33 + (lane & 31)] = 0.f; }
    }
    asm volatile("s_waitcnt lgkmcnt(0)" ::: "memory");
    const int c = lane & 7;
#pragma unroll
    for (int j = 0; j < 4; ++j) { const int n = (lane >> 3) + 8 * j; const LAS float* s = scr + (8 * c) * 33 + n;
        u32x4 o; o.x = pk2(s[0 * 33], s[1 * 33]); o.y = pk2(s[2 * 33], s[3 * 33]); o.z = pk2(s[4 * 33], s[5 * 33]); o.w = pk2(s[6 * 33], s[7 * 33]);
        *(u32x4*)(WT + (size_t)(dst_n0 + n) * dpitch + dk0 + k0 + 8 * c) = o; }
    asm volatile("s_waitcnt lgkmcnt(0)" ::: "memory");
}

__device__ __forceinline__ void convert_weights(const Params& p, int l, LAS unsigned char* lds, int gw, int NGW, int wave, int lane) {
    LAS float* scr = (LAS float*)(lds + wave * 16384);
    unsigned char* ws = p.ws;
    constexpr int I_IN = 32 * 392, I_13 = 32 * 352, I_2 = 88 * 64, I_O = 32 * 64, I_A = 8 * 64, I_G = 12 * 64, I_N = 12 * 64;
    constexpr int NIT = I_IN + I_13 + I_2 + I_O + I_A + I_G + I_N;
    for (int it = gw; it < NIT; it += NGW) {
        int r = it;
        if (r < I_IN) { const int kb = r / 392, nb = r % 392; const float* W = p.w_in + (size_t)l * DM * INC;
            int sb; if (nb < 120) sb = nb; else if (nb < 384) sb = nb + 1; else if (nb == 384) sb = 120; else sb = -1;
            transpose_item(sb >= 0 ? W : nullptr, DM, INC, sb * 32, (bf16*)(ws + WS_WIN), nb * 32, kb * 64, scr, lane); continue; } r -= I_IN;
        if (r < I_13) { const int kb = r / 352, nb = r % 352, pn = nb >> 3, wi = nb & 7;
            const float* W = ((wi >> 2) ? p.w3 : p.w1) + (size_t)l * DM * FF;
            transpose_item(W, DM, FF, (pn * 4 + (wi & 3)) * 32, (bf16*)(ws + WS_W13), nb * 32, kb * 64, scr, lane); continue; } r -= I_13;
        if (r < I_2) { const int kb = r / 64, nb = r % 64; transpose_item(p.w2 + (size_t)l * FF * DM, FF, DM, nb * 32, (bf16*)(ws + WS_W2), nb * 32, kb * 64, scr, lane); continue; } r -= I_2;
        if (r < I_O) { const int kb = r / 64, nb = r % 64; transpose_item(p.w_o + (size_t)l * DM * DM, DM, DM, nb * 32, (bf16*)(ws + WS_WO), nb * 32, kb * 64, scr, lane); continue; } r -= I_O;
        if (r < I_A) { const int kb = r / 64, nb = r % 64; transpose_item(p.w_a_out + (size_t)l * 512 * DM, 512, DM, nb * 32, (bf16*)(ws + WS_WM), nb * 32, kb * 64, scr, lane, DM, 0); continue; } r -= I_A;
        if (r < I_G) { const int kb = r / 64, nb = r % 64; transpose_item(p.w_g_out + (size_t)l * 768 * DM, 768, DM, nb * 32, (bf16*)(ws + WS_WM), nb * 32, kb * 64, scr, lane, DM, 512); continue; } r -= I_G;
        { const int kb = r / 64, nb = r % 64; transpose_item(p.w_n_out + (size_t)l * 768 * DM, 768, DM, nb * 32, (bf16*)(ws + WS_WM), nb * 32, kb * 64, scr, lane, DM, 1280); }
    }
}

__device__ __forceinline__ void adaln_item(const Params& p, int item, LAS unsigned char* lds, int tid, int wave, int lane) {
    const int l = item / 96, cb = item % 96;
    LAS float* sl = (LAS float*)lds;
    LAS float* red = (LAS float*)(lds + 24576);
    __syncthreads();
    for (int i = tid; i < 3 * DM; i += 512) { const int v = i / DM, k = i % DM; const float cv = v < 2 ? p.c[v * DM + k] : p.c_ctx[k]; sl[i] = siluf_(cv); }
    __syncthreads();
    const float* W = p.w_ada + (size_t)l * DM * ADA + cb * 128 + 2 * lane;
    float a00 = 0, a01 = 0, a10 = 0, a11 = 0, a20 = 0, a21 = 0;
    const int kbeg = wave * 256;
#pragma unroll 8
    for (int k = kbeg; k < kbeg + 256; ++k) {
        const f32x2 w = *(const f32x2*)(W + (size_t)k * ADA);
        const float s0 = sl[k], s1 = sl[DM + k], s2 = sl[2 * DM + k];
        a00 += s0 * w.x; a01 += s0 * w.y; a10 += s1 * w.x; a11 += s1 * w.y; a20 += s2 * w.x; a21 += s2 * w.y;
    }
    red[(wave * 3 + 0) * 128 + 2 * lane] = a00; red[(wave * 3 + 0) * 128 + 2 * lane + 1] = a01;
    red[(wave * 3 + 1) * 128 + 2 * lane] = a10; red[(wave * 3 + 1) * 128 + 2 * lane + 1] = a11;
    red[(wave * 3 + 2) * 128 + 2 * lane] = a20; red[(wave * 3 + 2) * 128 + 2 * lane + 1] = a21;
    __syncthreads();
    if (tid < 384) { const int v = tid / 128, j = tid % 128; float s = p.b_ada[l * ADA + cb * 128 + j];
#pragma unroll
        for (int w = 0; w < 8; ++w) s += red[(w * 3 + v) * 128 + j];
        ((float*)(p.ws + WS_MADA))[(size_t)(l * 3 + v) * ADA + cb * 128 + j] = s; }
}

__device__ __forceinline__ void norm_rows(const float* srcL, const float* srcC, const float* g, const float* mv, int sc_idx, int sh_idx, bf16* out, int nrows, int gw, int NGW, int lane, const float* part, int nsplit, float* wb) {
    for (int row = gw; row < nrows; row += NGW) {
        const bool isc = row >= ML;
        const f32x4* src = (const f32x4*)(isc ? srcC + (size_t)(row - ML) * DM : srcL + (size_t)row * DM) + lane;
        const float* mvv = mv + (isc ? 2 : (row >> 13)) * ADA;
        f32x4 v[8]; float s = 0.f;
#pragma unroll
        for (int j = 0; j < 8; ++j) v[j] = src[64 * j];
        if (isc && nsplit > 0) {
            const f32x4* pp = (const f32x4*)(part + (size_t)(row - ML) * DM) + lane;
#pragma unroll 4
            for (int sp = 0; sp < nsplit; ++sp) {
#pragma unroll
                for (int j = 0; j < 8; ++j) v[j] += pp[(size_t)sp * (MC * DM / 4) + 64 * j];
            }
            if (wb) { f32x4* w4 = (f32x4*)(wb + (size_t)(row - ML) * DM) + lane;
#pragma unroll
                for (int j = 0; j < 8; ++j) w4[64 * j] = v[j]; }
        }
#pragma unroll
        for (int j = 0; j < 8; ++j) s += (v[j].x * v[j].x + v[j].y * v[j].y) + (v[j].z * v[j].z + v[j].w * v[j].w);
        const float rstd = 1.f / sqrtf(wave_sum(s) * (1.f / DM) + 1e-6f);
        u32x2* o = (u32x2*)(out + (size_t)row * DM) + lane;
#pragma unroll
        for (int j = 0; j < 8; ++j) {
            const int col = 4 * (lane + 64 * j);
            const f32x4 gg = *(const f32x4*)(g + col), sc = *(const f32x4*)(mvv + sc_idx * DM + col), sh = *(const f32x4*)(mvv + sh_idx * DM + col);
            const f32x4 y = (v[j] * rstd) * gg * (sc + 1.f) + sh;
            u32x2 w; w.x = pk2(y.x, y.y); w.y = pk2(y.z, y.w); o[64 * j] = w;
        }
    }
}
__device__ __forceinline__ void final_norm(float* h, const float* g, int gw, int NGW, int lane) {
    for (int row = gw; row < ML; row += NGW) {
        f32x4* src = (f32x4*)(h + (size_t)row * DM) + lane;
        f32x4 v[8]; float s = 0.f;
#pragma unroll
        for (int j = 0; j < 8; ++j) { v[j] = src[64 * j]; s += (v[j].x * v[j].x + v[j].y * v[j].y) + (v[j].z * v[j].z + v[j].w * v[j].w); }
        const float rstd = 1.f / sqrtf(wave_sum(s) * (1.f / DM) + 1e-6f);
#pragma unroll
        for (int j = 0; j < 8; ++j) { const f32x4 gg = *(const f32x4*)(g + 4 * (lane + 64 * j)); src[64 * j] = (v[j] * rstd) * gg; }
    }
}

__device__ __forceinline__ void conv_loadu(const bf16* P, int row, int seq0, int seqlen, int ch, float (&u)[8]) {
    const int t = row - seq0;
    if (t < 0 || t >= seqlen) {
#pragma unroll
        for (int i = 0; i < 8; ++i) u[i] = 0.f;
    } else {
        const u32x4 a = *(const u32x4*)(P + (size_t)row * PS + C_AIN + ch), c = *(const u32x4*)(P + (size_t)row * PS + C_AC + ch);
        u[0] = bflo(a.x) * bflo(c.x); u[1] = bfhi(a.x) * bfhi(c.x); u[2] = bflo(a.y) * bflo(c.y); u[3] = bfhi(a.y) * bfhi(c.y);
        u[4] = bflo(a.z) * bflo(c.z); u[5] = bfhi(a.z) * bfhi(c.z); u[6] = bflo(a.w) * bflo(c.w); u[7] = bfhi(a.w) * bfhi(c.w);
    }
}
__device__ __forceinline__ void conv_item(const bf16* P, const float* cw, bf16* A, int item, int tid) {
    const int rbase = item * 64, ch = (tid & 63) * 8, r0 = rbase + (tid >> 6) * 8;
    const int seqlen = rbase >= ML ? CTX : SEQ, seq0 = rbase >= ML ? ML + ((rbase - ML) / CTX) * CTX : (rbase / SEQ) * SEQ;
    float w0[8], w1[8], w2[8];
#pragma unroll
    for (int i = 0; i < 8; ++i) { w0[i] = cw[ch + i]; w1[i] = cw[512 + ch + i]; w2[i] = cw[1024 + ch + i]; }
    float up[8], uc[8], un[8];
    conv_loadu(P, r0 - 1, seq0, seqlen, ch, up); conv_loadu(P, r0, seq0, seqlen, ch, uc);
#pragma unroll
    for (int r = 0; r < 8; ++r) {
        conv_loadu(P, r0 + r + 1, seq0, seqlen, ch, un);
        const u32x4 b = *(const u32x4*)(P + (size_t)(r0 + r) * PS + C_AB + ch);
        float o[8];
#pragma unroll
        for (int i = 0; i < 8; ++i) o[i] = w0[i] * up[i] + w1[i] * uc[i] + w2[i] * un[i];
        o[0] *= bflo(b.x); o[1] *= bfhi(b.x); o[2] *= bflo(b.y); o[3] *= bfhi(b.y); o[4] *= bflo(b.z); o[5] *= bfhi(b.z); o[6] *= bflo(b.w); o[7] *= bfhi(b.w);
        u32x4 w; w.x = pk2(o[0], o[1]); w.y = pk2(o[2], o[3]); w.z = pk2(o[4], o[5]); w.w = pk2(o[6], o[7]);
        *(u32x4*)(A + (size_t)(r0 + r) * DM + ch) = w;
#pragma unroll
        for (int i = 0; i < 8; ++i) { up[i] = uc[i]; uc[i] = un[i]; }
    }
}

struct NaQ { bf16x8 qf[4]; f32x4 o[8]; float m, l; };
template <int NJ> __device__ __forceinline__ void na_softmax(f32x4 (&s)[NJ], float mx, NaQ& Q) {
    mx = xrow16_max(mx);
    const float mnew = fmaxf(Q.m, mx), alpha = __builtin_amdgcn_exp2f(Q.m - mnew); Q.m = mnew;
    float ps = 0.f;
#pragma unroll
    for (int t = 0; t < NJ; ++t)
#pragma unroll
        for (int e = 0; e < 4; ++e) { const float pe = __builtin_amdgcn_exp2f(s[t][e] - mnew); s[t][e] = pe; ps += pe; }
    Q.l = Q.l * alpha + ps;
    if (__builtin_amdgcn_ballot_w64(alpha != 1.f) != 0ull) {
#pragma unroll
        for (int i = 0; i < 8; ++i) Q.o[i] *= alpha;
    }
}
template <bool ISL, bool DOA, bool DOB>
__device__ __forceinline__ void na_block(const LAS bf16* Ks, const LAS bf16* Vs, NaQ& A, NaQ& B, int ja, int jb, int fr, int fq, const LAS float* bpA, const LAS float* bpB, int cs, float scale2) {
    constexpr int NJ = 2;
    f32x4 sA[NJ], sB[NJ]; float mxA = -INFINITY, mxB = -INFINITY;
#pragma unroll
    for (int t = 0; t < NJ; ++t) {
        const int j = t ? jb : ja;
        sA[t] = (f32x4){0.f, 0.f, 0.f, 0.f}; sB[t] = (f32x4){0.f, 0.f, 0.f, 0.f};
        const LAS bf16* kp = Ks + (16 * j + fr) * 136 + 8 * fq;
#pragma unroll
        for (int kk = 0; kk < 4; ++kk) { const bf16x8 X = *(const LAS bf16x8*)(kp + 32 * kk);
            if (DOA) sA[t] = MFMA16(X, A.qf[kk], sA[t]);
            if (DOB) sB[t] = MFMA16(X, B.qf[kk], sB[t]); }
#pragma unroll
        for (int e = 0; e < 4; ++e) {
            if (ISL) { const int kc = 16 * j + 4 * fq + e; const bool valid = (unsigned)(kc - cs) < 16u; const int bi = valid ? kc : 0;
                if (DOA) { const float bv = bpA[bi]; const float v = valid ? sA[t][e] * scale2 + bv : -INFINITY; sA[t][e] = v; mxA = fmaxf(mxA, v); }
                if (DOB) { const float bv = bpB[bi]; const float v = valid ? sB[t][e] * scale2 + bv : -INFINITY; sB[t][e] = v; mxB = fmaxf(mxB, v); }
            } else {
                if (DOA) { const float v = sA[t][e] * scale2; sA[t][e] = v; mxA = fmaxf(mxA, v); }
                if (DOB) { const float v = sB[t][e] * scale2; sB[t][e] = v; mxB = fmaxf(mxB, v); }
            }
        }
        __builtin_amdgcn_sched_barrier(0);
    }
    if (DOA) na_softmax<NJ>(sA, mxA, A);
    if (DOB) na_softmax<NJ>(sB, mxB, B);
#pragma unroll
    for (int g2 = 0; g2 < NJ / 2; ++g2) {
        const int j0 = ja, j1 = jb;
        bf16x8 YA = (bf16x8){0, 0, 0, 0, 0, 0, 0, 0}, YB = YA;
        if (DOA) { u32x4 yw; yw.x = pk2(sA[2 * g2][0], sA[2 * g2][1]); yw.y = pk2(sA[2 * g2][2], sA[2 * g2][3]); yw.z = pk2(sA[2 * g2 + 1][0], sA[2 * g2 + 1][1]); yw.w = pk2(sA[2 * g2 + 1][2], sA[2 * g2 + 1][3]); YA = __builtin_bit_cast(bf16x8, yw); }
        if (DOB) { u32x4 yw; yw.x = pk2(sB[2 * g2][0], sB[2 * g2][1]); yw.y = pk2(sB[2 * g2][2], sB[2 * g2][3]); yw.z = pk2(sB[2 * g2 + 1][0], sB[2 * g2 + 1][1]); yw.w = pk2(sB[2 * g2 + 1][2], sB[2 * g2 + 1][3]); YB = __builtin_bit_cast(bf16x8, yw); }
        const LAS bf16* v0 = Vs + (16 * j0 + 4 * fq + (fr >> 2)) * 136 + 4 * (fr & 3);
        const LAS bf16* v1 = Vs + (16 * j1 + 4 * fq + (fr >> 2)) * 136 + 4 * (fr & 3);
#pragma unroll
        for (int dvb = 0; dvb < 8; ++dvb) { const bf16x8 X = cat4(tr_read(v0 + 16 * dvb), tr_read(v1 + 16 * dvb));
            if (DOA) A.o[dvb] = MFMA16(X, YA, A.o[dvb]);
            if (DOB) B.o[dvb] = MFMA16(X, YB, B.o[dvb]);
            if ((dvb & 3) == 3) __builtin_amdgcn_sched_barrier(0); }
    }
}
__device__ __forceinline__ void na_store(const NaQ& Q, bf16* O, size_t qrow, int h, int fq) {
    const float l = xrow16_sum(Q.l);
    const float inv = 1.f / l;
#pragma unroll
    for (int dvb = 0; dvb < 8; ++dvb) { u32x2 w; w.x = pk2(Q.o[dvb][0] * inv, Q.o[dvb][1] * inv); w.y = pk2(Q.o[dvb][2] * inv, Q.o[dvb][3] * inv);
        *(u32x2*)(O + qrow * DM + 1280 + h * 128 + 16 * dvb + 4 * fq) = w; }
}
__device__ __forceinline__ void na_item(LAS unsigned char* lds, const bf16* P, const float* rpb, bf16* O, int b, int h, int rp, int qhalf, int tid, int wave, int lane) {
    LAS float* bias = (LAS float*)(lds + 69632);
    const int fr = lane & 15, fq = lane >> 4, g = wave & 3;
    const bool loc = rp >= 0;
    int rA = 0, qc = 0, cs = 0, ja = 0, jb = 1, rsA = 0, kr_lo = 0, nloc = 0; size_t qrowA;
    if (loc) { rA = 2 * rp + (wave >> 2); qc = g == 0 ? (fr < 8 ? fr : 48 + fr) : 16 * g - 8 + fr; cs = min(max(qc - 8, 0), 48); ja = g == 0 ? 0 : g - 1; jb = g == 0 ? 3 : g;
        qrowA = (size_t)b * SEQ + rA * 64 + qc; rsA = min(max(rA - 4, 0), 120);
        kr_lo = min(max(2 * rp - 4, 0), 120); const int kr_hi = min(max(2 * rp - 3, 0), 120) + 7; nloc = kr_hi - kr_lo + 1; }
    else qrowA = (size_t)ML + b * CTX + 128 * qhalf + 16 * wave + fr;
    NaQ A;
#pragma unroll
    for (int kk = 0; kk < 4; ++kk) A.qf[kk] = *(const bf16x8*)(P + qrowA * PS + C_NQ + h * 128 + 32 * kk + 8 * fq);
#pragma unroll
    for (int i = 0; i < 8; ++i) A.o[i] = (f32x4){0.f, 0.f, 0.f, 0.f};
    A.m = -1e30f; A.l = 0.f;
    __syncthreads();
    if (loc && tid < 465) bias[tid] = rpb[h * 465 + tid] * 1.4426950408889634f;
    const float scale2 = 0.08838834764831845f * 1.4426950408889634f;
    const int nblk = nloc + 4;
    u32x4 kreg[2], vreg[2];
#define NA_LOAD(blk_) do { const int b_ = (blk_); const size_t kro_ = b_ < nloc ? (size_t)b * SEQ + (kr_lo + b_) * 64 : (size_t)ML + b * CTX + 64 * (b_ - nloc); \
        _Pragma("unroll") for (int i = 0; i < 2; ++i) { const int c = tid + 512 * i, key = c >> 4, part = c & 15; const bf16* src = P + (kro_ + key) * PS + h * 128 + part * 8; \
            kreg[i] = *(const u32x4*)(src + C_NK); vreg[i] = *(const u32x4*)(src + C_NV); } } while (0)
    NA_LOAD(0);
    for (int blk = 0; blk < nblk; ++blk) {
        const bool isl = blk < nloc; const int kr = kr_lo + blk;
        LAS bf16* Ks = (LAS bf16*)(lds + (blk & 1) * 34816); LAS bf16* Vs = Ks + 64 * 136;
#pragma unroll
        for (int i = 0; i < 2; ++i) { const int c = tid + 512 * i, key = c >> 4, part = c & 15;
            *(LAS u32x4*)(Ks + key * 136 + part * 8) = kreg[i]; *(LAS u32x4*)(Vs + key * 136 + part * 8) = vreg[i]; }
        if (blk + 1 < nblk) NA_LOAD(blk + 1);
        __syncthreads();
        if (isl) {
            if (kr >= rsA && kr < rsA + 8) { const LAS float* bpA = bias + ((kr - rA + 7) * 31 - qc + 15);
                na_block<true, true, false>(Ks, Vs, A, A, ja, jb, fr, fq, bpA, bpA, cs, scale2); }
        } else { na_block<false, true, false>(Ks, Vs, A, A, 0, 1, fr, fq, bias, bias, 0, scale2); na_block<false, true, false>(Ks, Vs, A, A, 2, 3, fr, fq, bias, bias, 0, scale2); }
    }
#undef NA_LOAD
    na_store(A, O, qrowA, h, fq);
}

struct GlaPre { float al[4], wl[4], bsv; };
__device__ __forceinline__ void gla_decays_load(GlaPre& g, const Params& p, int l, size_t rowbase, int h, int tid) {
    const float* alpha = (const float*)(p.ws + WS_ALPHA) + rowbase * 32;
#pragma unroll
    for (int j = 0; j < 4; ++j) { const int i = tid + 512 * j; g.al[j] = alpha[i]; const int dir = i >> 10, r = (i >> 6) & 15, d = i & 63; g.wl[j] = (dir ? p.wa_b : p.wa_f)[(size_t)l * 16 * 384 + r * 384 + h * 64 + d]; }
    g.bsv = (((tid >> 6) & 1) ? p.ba_b : p.ba_f)[l * 384 + h * 64 + (tid & 63)];
}
__device__ __forceinline__ void gla_decays(LAS unsigned char* lds, const GlaPre& g, int tid) {
    LAS float* LAF = (LAS float*)lds; LAS float* LAB = (LAS float*)(lds + 16384); LAS float* AL = (LAS float*)(lds + 32768); LAS float* WAL = (LAS float*)(lds + 40960);
    __syncthreads();
#pragma unroll
    for (int j = 0; j < 4; ++j) { AL[tid + 512 * j] = g.al[j]; WAL[tid + 512 * j] = g.wl[j]; }
    __syncthreads();
    {
        const int d = tid & 63, dir = (tid >> 6) & 1, tg = tid >> 7;
        float wa[16];
#pragma unroll
        for (int r = 0; r < 16; ++r) wa[r] = WAL[dir * 1024 + r * 64 + d];
        const float bsv = g.bsv;
        LAS float* LA = dir ? LAB : LAF;
#pragma unroll 4
        for (int i = 0; i < 16; ++i) { const int t = tg * 16 + i; float z = bsv;
#pragma unroll
            for (int r = 0; r < 16; ++r) z += AL[t * 32 + dir * 16 + r] * wa[r];
            const float ls = fminf(z, 0.f) - __builtin_amdgcn_logf(1.f + fast_exp(-fabsf(z))) * 0.6931471805599453f;
            LA[t * 64 + d] = ls * 0.0625f; }
    }
    __syncthreads();
    if (tid < 128) { const int d = tid & 63; const bool fwd = tid < 64; LAS float* LA = fwd ? LAF : LAB; float run = 0.f;
#pragma unroll
        for (int hh = 0; hh < 2; ++hh) { float v[32]; const int t0 = fwd ? 32 * hh : 32 * (1 - hh);
#pragma unroll
            for (int t = 0; t < 32; ++t) v[t] = LA[(t0 + t) * 64 + d];
            if (fwd) {
#pragma unroll
                for (int t = 0; t < 32; ++t) { run += v[t]; v[t] = run; } }
            else {
#pragma unroll
                for (int t = 31; t >= 0; --t) { run += v[t]; v[t] = run; } }
#pragma unroll
            for (int t = 0; t < 32; ++t) LA[(t0 + t) * 64 + d] = v[t]; } }
    __syncthreads();
}
__device__ __forceinline__ void load_rope(u32x2 a, u32x2 c, bool is_lat, const float (&cs)[4], const float (&sn)[4], float (&lo)[4], float (&hi)[4]) {
    float x1[4] = {bflo(a.x), bfhi(a.x), bflo(a.y), bfhi(a.y)}, x2[4] = {bflo(c.x), bfhi(c.x), bflo(c.y), bfhi(c.y)};
#pragma unroll
    for (int e = 0; e < 4; ++e) { if (is_lat) { lo[e] = x1[e] * cs[e] - x2[e] * sn[e]; hi[e] = x1[e] * sn[e] + x2[e] * cs[e]; } else { lo[e] = x1[e]; hi[e] = x2[e]; } }
}
__device__ __forceinline__ void rope_cs(int grow, int s, int i4, float (&cs)[4], float (&sn)[4]) {
#pragma unroll
    for (int e = 0; e < 4; ++e) { const int i = i4 + e; const float inv = __builtin_amdgcn_exp2f(-(float)(i & 15) * 0.8304820237218406f);
        const float ang = (float)(i < 16 ? grow : s) * inv; float f = ang * 0.15915494309189535f; f -= floorf(f);
        sn[e] = __builtin_amdgcn_sinf(f); cs[e] = __builtin_amdgcn_cosf(f); }
}
__device__ __forceinline__ void st4(LAS bf16* dst, float a, float b, float c, float d) { u32x2 w; w.x = pk2(a, b); w.y = pk2(c, d); *(LAS u32x2*)dst = w; }

__device__ __forceinline__ void gla1_item(LAS unsigned char* lds, const Params& p, int l, int b, int h, int ci, int tid, int wave, int lane) {
    const bf16* P = (const bf16*)(p.ws + WS_P);
    const bool is_lat = ci >= 4; const int grow = ci - 4;
    const size_t rowbase = is_lat ? (size_t)b * SEQ + 64 * grow : (size_t)ML + b * CTX + 64 * ci;
    GlaPre gp; gla_decays_load(gp, p, l, rowbase, h, tid);
    const bf16* ksrc = P + (rowbase + (tid >> 3)) * PS + C_GK + h * 64 + (tid & 7) * 4;
    const u32x2 k_a = *(const u32x2*)ksrc, k_c = *(const u32x2*)(ksrc + 32);
    u32x4 vpre[2];
#pragma unroll
    for (int i = 0; i < 2; ++i) { const int c = tid + 512 * i, key = c >> 4, part = c & 15; vpre[i] = *(const u32x4*)(P + (rowbase + key) * PS + C_GV + h * 128 + part * 8); }
    gla_decays(lds, gp, tid);
    LAS float* LAF = (LAS float*)lds; LAS float* LAB = (LAS float*)(lds + 16384);
    LAS bf16* KF = (LAS bf16*)(lds + 49152); LAS bf16* KB = (LAS bf16*)(lds + 58368); LAS bf16* Vs = (LAS bf16*)(lds + 67584);
    {
        const int s = tid >> 3, i4 = (tid & 7) * 4; float cs[4], sn[4], lo[4], hi[4];
        rope_cs(grow, s, i4, cs, sn);
        load_rope(k_a, k_c, is_lat, cs, sn, lo, hi);
        float fl[4], fh[4], bl[4], bh[4];
#pragma unroll
        for (int e = 0; e < 4; ++e) { const int i = i4 + e;
            fl[e] = lo[e] * fast_exp(LAF[63 * 64 + i] - LAF[s * 64 + i]); fh[e] = hi[e] * fast_exp(LAF[63 * 64 + i + 32] - LAF[s * 64 + i + 32]);
            bl[e] = lo[e] * fast_exp(LAB[i] - LAB[s * 64 + i]); bh[e] = hi[e] * fast_exp(LAB[i + 32] - LAB[s * 64 + i + 32]); }
        st4(KF + s * 72 + i4, fl[0], fl[1], fl[2], fl[3]); st4(KF + s * 72 + i4 + 32, fh[0], fh[1], fh[2], fh[3]);
        st4(KB + s * 72 + i4, bl[0], bl[1], bl[2], bl[3]); st4(KB + s * 72 + i4 + 32, bh[0], bh[1], bh[2], bh[3]);
#pragma unroll
        for (int i = 0; i < 2; ++i) { const int c = tid + 512 * i, key = c >> 4, part = c & 15; *(LAS u32x4*)(Vs + key * 136 + part * 8) = vpre[i]; }
    }
    __syncthreads();
    const int fr = lane & 15, fq = lane >> 4, dir = wave >> 2, dkb = wave & 3;
    LAS bf16* UT = (LAS bf16*)(lds + 86016);
    {
        const LAS bf16* Kh = dir ? KB : KF;
        bf16x8 Y[2];
#pragma unroll
        for (int ks = 0; ks < 2; ++ks) { const LAS bf16* a1 = Kh + (32 * ks + 8 * fq + (fr >> 2)) * 72 + 16 * dkb + 4 * (fr & 3); Y[ks] = cat4(tr_read(a1), tr_read(a1 + 4 * 72)); }
#pragma unroll
        for (int dvb = 0; dvb < 8; ++dvb) { f32x4 acc = (f32x4){0.f, 0.f, 0.f, 0.f};
#pragma unroll
            for (int ks = 0; ks < 2; ++ks) { const LAS bf16* x1 = Vs + (32 * ks + 8 * fq + (fr >> 2)) * 136 + 16 * dvb + 4 * (fr & 3); const bf16x8 X = cat4(tr_read(x1), tr_read(x1 + 4 * 136)); acc = MFMA16(Y[ks], X, acc); }
            st4(UT + (dir * 128 + 16 * dvb + fr) * 72 + 16 * dkb + 4 * fq, acc[0], acc[1], acc[2], acc[3]); }
    }
    __syncthreads();
#pragma unroll
    for (int i = 0; i < 4; ++i) { const int c = tid + 512 * i, dd = c >> 10, row = (c >> 3) & 127, part = c & 7;
        const int ch2 = (b * 6 + h) * 2 + dd, ps2 = dd ? (is_lat ? 135 - ci : 3 - ci) : ci;
        *(u32x4*)((bf16*)(p.ws + WS_UBUF) + ((size_t)ch2 * NCH + ps2) * 8192 + row * 64 + part * 8) = *(const LAS u32x4*)(UT + (dd * 128 + row) * 72 + part * 8); }
    if (tid < 128) { const int dd = tid >> 6, d = tid & 63; const int ch2 = (b * 6 + h) * 2 + dd, ps2 = dd ? (is_lat ? 135 - ci : 3 - ci) : ci;
        ((float*)(p.ws + WS_DBUF))[((size_t)ch2 * NCH + ps2) * 64 + d] = fast_exp(dd ? LAB[d] : LAF[63 * 64 + d]); }
}

__device__ __forceinline__ void gla_scan(bf16* U, const float* D, int gtid, int nthr) {
    for (int idx = gtid; idx < 24 * 4096; idx += nthr) {
        const int chain = idx >> 12, e = (idx & 4095) * 2, dk = e & 63;
        unsigned* u = (unsigned*)(U + (size_t)chain * NCH * 8192 + e); const f32x2* d = (const f32x2*)(D + (size_t)chain * NCH * 64 + dk); f32x2 S = (f32x2){0.f, 0.f};
        for (int p0 = 0; p0 < NCH; p0 += 22) {
            unsigned uu[22]; f32x2 dd[22];
#pragma unroll
            for (int i = 0; i < 22; ++i) { uu[i] = u[(size_t)(p0 + i) * 4096]; dd[i] = d[(p0 + i) * 32]; }
#pragma unroll
            for (int i = 0; i < 22; ++i) { u[(size_t)(p0 + i) * 4096] = pk2(S.x, S.y); S.x = dd[i].x * S.x + bflo(uu[i]); S.y = dd[i].y * S.y + bfhi(uu[i]); }
        }
    }
}

__device__ __forceinline__ void gla3_item(LAS unsigned char* lds, const Params& p, int l, int b, int h, int ci, int tid, int wave, int lane) {
    const bf16* P = (const bf16*)(p.ws + WS_P);
    const bool is_lat = ci >= 4; const int grow = ci - 4;
    const size_t rowbase = is_lat ? (size_t)b * SEQ + 64 * grow : (size_t)ML + b * CTX + 64 * ci;
    GlaPre gp; gla_decays_load(gp, p, l, rowbase, h, tid);
    const bf16* ksrc = P + (rowbase + (tid >> 3)) * PS + C_GK + h * 64 + (tid & 7) * 4;
    const u32x2 k_a = *(const u32x2*)ksrc, k_c = *(const u32x2*)(ksrc + 32), q_a = *(const u32x2*)(ksrc + (C_GQ - C_GK)), q_c = *(const u32x2*)(ksrc + (C_GQ - C_GK) + 32);
    u32x4 vpre[2];
#pragma unroll
    for (int i = 0; i < 2; ++i) { const int c = tid + 512 * i, key = c >> 4, part = c & 15; vpre[i] = *(const u32x4*)(P + (rowbase + key) * PS + C_GV + h * 128 + part * 8); }
    u32x4 spre[2][2];
#pragma unroll
    for (int dir = 0; dir < 2; ++dir) { const int chain = (b * 6 + h) * 2 + dir, pos = dir ? (is_lat ? 135 - ci : 3 - ci) : ci;
        const bf16* src = (const bf16*)(p.ws + WS_UBUF) + ((size_t)chain * NCH + pos) * 8192 + (tid >> 2) * 64 + (tid & 3) * 16;
        spre[dir][0] = *(const u32x4*)src; spre[dir][1] = *(const u32x4*)(src + 8); }
    gla_decays(lds, gp, tid);
    LAS float* LAF = (LAS float*)lds; LAS float* LAB = (LAS float*)(lds + 16384);
    LAS bf16* AM = (LAS bf16*)(lds + 32768); LAS bf16* QF = (LAS bf16*)(lds + 49152); LAS bf16* QB = (LAS bf16*)(lds + 58368);
    LAS bf16* KF = (LAS bf16*)(lds + 67584); LAS bf16* KB = (LAS bf16*)(lds + 76800); LAS bf16* Vs = (LAS bf16*)(lds + 86016);
    LAS bf16* SF = (LAS bf16*)(lds + 103424); LAS bf16* SB = (LAS bf16*)(lds + 121856); LAS float* SSQ = (LAS float*)(lds + 140288);
    {
        const int s = tid >> 3, i4 = (tid & 7) * 4; float cs[4], sn[4], klo[4], khi[4], qlo[4], qhi[4];
        rope_cs(grow, s, i4, cs, sn);
        load_rope(k_a, k_c, is_lat, cs, sn, klo, khi);
        load_rope(q_a, q_c, is_lat, cs, sn, qlo, qhi);
        float o1[4], o2[4], o3[4], o4[4];
#pragma unroll
        for (int half = 0; half < 2; ++half) {
#pragma unroll
            for (int e = 0; e < 4; ++e) { const int i = i4 + e + 32 * half; const float bf = LAF[s * 64 + i] - LAF[31 * 64 + i], cb = LAB[s * 64 + i] - LAB[32 * 64 + i];
                const float q = (half ? qhi[e] : qlo[e]) * 0.125f, k = half ? khi[e] : klo[e];
                o1[e] = q * fast_exp(bf); o2[e] = k * fast_exp(-bf); o3[e] = q * fast_exp(cb); o4[e] = k * fast_exp(-cb); }
            st4(QF + s * 72 + i4 + 32 * half, o1[0], o1[1], o1[2], o1[3]); st4(KF + s * 72 + i4 + 32 * half, o2[0], o2[1], o2[2], o2[3]);
            st4(QB + s * 72 + i4 + 32 * half, o3[0], o3[1], o3[2], o3[3]); st4(KB + s * 72 + i4 + 32 * half, o4[0], o4[1], o4[2], o4[3]);
        }
#pragma unroll
        for (int i = 0; i < 2; ++i) { const int c = tid + 512 * i, key = c >> 4, part = c & 15; *(LAS u32x4*)(Vs + key * 136 + part * 8) = vpre[i]; }
        const int dv = tid >> 2, d16 = (tid & 3) * 16;
#pragma unroll
        for (int dir = 0; dir < 2; ++dir) {
            const u32x4 r0 = spre[dir][0], r1 = spre[dir][1];
            f32x4 a0 = (f32x4){bflo(r0.x), bfhi(r0.x), bflo(r0.y), bfhi(r0.y)}, a1 = (f32x4){bflo(r0.z), bfhi(r0.z), bflo(r0.w), bfhi(r0.w)};
            f32x4 a2 = (f32x4){bflo(r1.x), bfhi(r1.x), bflo(r1.y), bfhi(r1.y)}, a3 = (f32x4){bflo(r1.z), bfhi(r1.z), bflo(r1.w), bfhi(r1.w)};
            { const LAS float* mid = dir ? LAB + 32 * 64 + d16 : LAF + 31 * 64 + d16;
#pragma unroll
              for (int j = 0; j < 4; ++j) { a0[j] *= fast_exp(mid[j]); a1[j] *= fast_exp(mid[4 + j]); a2[j] *= fast_exp(mid[8 + j]); a3[j] *= fast_exp(mid[12 + j]); } }
            LAS bf16* dst = (dir ? SB : SF) + dv * 72 + d16;
            u32x4 w0, w1; w0.x = pk2(a0[0], a0[1]); w0.y = pk2(a0[2], a0[3]); w0.z = pk2(a1[0], a1[1]); w0.w = pk2(a1[2], a1[3]);
            w1.x = pk2(a2[0], a2[1]); w1.y = pk2(a2[2], a2[3]); w1.z = pk2(a3[0], a3[1]); w1.w = pk2(a3[2], a3[3]);
            *(LAS u32x4*)dst = w0; *(LAS u32x4*)(dst + 8) = w1; }
    }
    __syncthreads();
    const int fr = lane & 15, fq = lane >> 4, tb = wave & 3, wh = wave >> 2;
#pragma unroll
    for (int q2 = 0; q2 < 2; ++q2) { const int sb = 2 * wh + q2; f32x4 af = (f32x4){0.f, 0.f, 0.f, 0.f}, ab = (f32x4){0.f, 0.f, 0.f, 0.f};
        if (sb <= tb) {
#pragma unroll
            for (int ks = 0; ks < 2; ++ks) { const bf16x8 X = *(const LAS bf16x8*)(KF + (16 * sb + fr) * 72 + 32 * ks + 8 * fq), Y = *(const LAS bf16x8*)(QF + (16 * tb + fr) * 72 + 32 * ks + 8 * fq); af = MFMA16(X, Y, af); } }
        if (sb >= tb) {
#pragma unroll
            for (int ks = 0; ks < 2; ++ks) { const bf16x8 X = *(const LAS bf16x8*)(KB + (16 * sb + fr) * 72 + 32 * ks + 8 * fq), Y = *(const LAS bf16x8*)(QB + (16 * tb + fr) * 72 + 32 * ks + 8 * fq); ab = MFMA16(X, Y, ab); } }
        const int t = 16 * tb + fr; float r[4];
#pragma unroll
        for (int e = 0; e < 4; ++e) { const int s = 16 * sb + 4 * fq + e; r[e] = (s <= t ? af[e] : 0.f) + (s >= t ? ab[e] : 0.f); }
        st4(AM + t * 72 + 16 * sb + 4 * fq, r[0], r[1], r[2], r[3]); }
    __syncthreads();
    bf16x8 Ya[2], Yf[2], Yb[2];
#pragma unroll
    for (int ks = 0; ks < 2; ++ks) { Ya[ks] = *(const LAS bf16x8*)(AM + (16 * tb + fr) * 72 + 32 * ks + 8 * fq); Yf[ks] = *(const LAS bf16x8*)(QF + (16 * tb + fr) * 72 + 32 * ks + 8 * fq); Yb[ks] = *(const LAS bf16x8*)(QB + (16 * tb + fr) * 72 + 32 * ks + 8 * fq); }
    f32x4 acc[4]; float ssq = 0.f;
#pragma unroll
    for (int q = 0; q < 4; ++q) { const int dvb = 4 * wh + q; acc[q] = (f32x4){0.f, 0.f, 0.f, 0.f};
#pragma unroll
        for (int ks = 0; ks < 2; ++ks) { const LAS bf16* x1 = Vs + (32 * ks + 8 * fq + (fr >> 2)) * 136 + 16 * dvb + 4 * (fr & 3); const bf16x8 X = cat4(tr_read(x1), tr_read(x1 + 4 * 136)); acc[q] = MFMA16(X, Ya[ks], acc[q]); }
#pragma unroll
        for (int ks = 0; ks < 2; ++ks) { const bf16x8 X = *(const LAS bf16x8*)(SF + (16 * dvb + fr) * 72 + 32 * ks + 8 * fq); acc[q] = MFMA16(X, Yf[ks], acc[q]); }
#pragma unroll
        for (int ks = 0; ks < 2; ++ks) { const bf16x8 X = *(const LAS bf16x8*)(SB + (16 * dvb + fr) * 72 + 32 * ks + 8 * fq); acc[q] = MFMA16(X, Yb[ks], acc[q]); }
        ssq += (acc[q][0] * acc[q][0] + acc[q][1] * acc[q][1]) + (acc[q][2] * acc[q][2] + acc[q][3] * acc[q][3]); }
    ssq = xrow16_sum(ssq);
    if (fq == 0) SSQ[wh * 64 + 16 * tb + fr] = ssq;
    __syncthreads();
    const float rstd = 1.f / sqrtf((SSQ[16 * tb + fr] + SSQ[64 + 16 * tb + fr]) * (1.f / 128.f) + 1e-6f);
    const size_t row = rowbase + 16 * tb + fr;
    bf16* G = (bf16*)(p.ws + WS_BR);
#pragma unroll
    for (int q = 0; q < 4; ++q) { const int dv0 = 16 * (4 * wh + q) + 4 * fq;
        const f32x4 gn = *(const f32x4*)(p.g_norm + l * 128 + dv0); const u32x2 rr = *(const u32x2*)(P + row * PS + C_GR + h * 128 + dv0);
        const float o0 = acc[q][0] * rstd * gn[0] * siluf_(bflo(rr.x)), o1 = acc[q][1] * rstd * gn[1] * siluf_(bfhi(rr.x)), o2 = acc[q][2] * rstd * gn[2] * siluf_(bflo(rr.y)), o3 = acc[q][3] * rstd * gn[3] * siluf_(bfhi(rr.y));
        u32x2 w; w.x = pk2(o0, o1); w.y = pk2(o2, o3); *(u32x2*)(G + row * DM + 512 + h * 128 + dv0) = w; }
}

#ifndef REP_P0
#define REP_P0 1
#endif
#ifndef REP_N
#define REP_N 1
#endif
#ifndef REP_X1
#define REP_X1 1
#endif
#ifndef REP_X3
#define REP_X3 1
#endif
#ifndef REP_G1
#define REP_G1 1
#endif
#ifndef REP_F1
#define REP_F1 1
#endif
#ifndef REP_M
#define REP_M 1
#endif
#ifndef REP_O1
#define REP_O1 1
#endif
#ifndef REP_F2
#define REP_F2 1
#endif
#ifndef REP_NA
#define REP_NA 1
#endif
#ifndef REP_GL1
#define REP_GL1 1
#endif
#ifndef REP_SYNC
#define REP_SYNC 1
#endif
#define GSYNC() do { for (int r_ = 0; r_ < REP_SYNC; ++r_) xcd_barrier(xbar); } while (0)
typedef const Params __attribute__((address_space(4)))* ParamsCP;
#define PH ParamsCP pp_ = (ParamsCP)__builtin_amdgcn_kernarg_segment_ptr(); asm volatile("" : "+s"(pp_)); Params p; __builtin_memcpy(&p, pp_, sizeof(Params)); \
    int tid_ = threadIdx.x; asm volatile("" : "+v"(tid_)); const int tid = tid_, lane = tid & 63, wave = __builtin_amdgcn_readfirstlane(tid >> 6), gw = bx * 8 + wave; (void)lane; (void)gw; (void)tid; \
    unsigned char* ws = p.ws; float* mada = (float*)(ws + WS_MADA); float* hc = (float*)(ws + WS_HC); bf16* NBUF = (bf16*)(ws + WS_NBUF); bf16* P = (bf16*)(ws + WS_P); \
    bf16* BR = (bf16*)(ws + WS_BR); float* PART = (float*)(ws + WS_UBUF); \
    const bool need_ctx = (l == 0); const float* mv = mada + (size_t)l * 3 * ADA; const float* hL = l == 0 ? p.x : p.out; const float* hC = l == 0 ? p.ctx : hc; const int Mrows = need_ctx ? MT : ML; \
    (void)mada; (void)hc; (void)NBUF; (void)P; (void)BR; (void)PART; (void)mv; (void)hL; (void)hC; (void)Mrows;

__global__ void __launch_bounds__(512, 2) mega_fwd(Params p_unused) {
#if defined(__HIP_DEVICE_COMPILE__)
    extern __shared__ __attribute__((aligned(16))) unsigned char lds_raw[];
    cg::grid_group grid = cg::this_grid();
    LAS unsigned char* lds = (LAS unsigned char*)lds_raw;
    volatile LAS unsigned* MISC = (volatile LAS unsigned*)(lds + LDS_BYTES - 64);
    if (threadIdx.x < 16) MISC[threadIdx.x] = 0u;
    __syncthreads();
    const int G = gridDim.x, bx = blockIdx.x, NGW = G * 8;
    XcdBarrier xbar;
    { const int l = 0; PH xbar = xcd_barrier_post((unsigned*)p.ws, MISC); }

    for (int rep = 0; rep < REP_P0; ++rep) { const int l = 0; PH
        for (int it = bx; it < 192; it += G) adaln_item(p, it, lds, tid, wave, lane);
        __syncthreads();
        convert_weights(p, 0, lds, gw, NGW, wave, lane); }
    if (G == 0x7fffffff) grid.sync();
    GSYNC();

#pragma unroll 1
    for (int l = 0; l < 2; ++l) {
        for (int rep = 0; rep < REP_N; ++rep) { PH
            if (l == 1) convert_weights(p, 1, lds, gw, NGW, wave, lane);
            norm_rows(hL, hC, p.g_mix + l * DM, mv, 1, 0, NBUF, MT, gw, NGW, lane, PART, l == 1 ? 11 : 0, nullptr); }
        GSYNC();

        for (int rep = 0; rep < REP_G1; ++rep) { PH
            pg8::Gemm g{NBUF, (const bf16*)(ws + WS_WIN), MT, NINP, DM}; pg8::StaticOrder S; S.init(MT, NINP, G, bx);
            pg8::EpiInproj E{P, (float*)(ws + WS_ALPHA)};
            pg8::gemm_phase<pg8::EpiInproj, pg8::StaticOrder, true, true>(lds, g, S, E); }
        GSYNC();

        for (int rep = 0; rep < REP_X1; ++rep) { PH
            const int nNA = 768 + (need_ctx ? 24 : 0), nG1 = 2 * 6 * NCH, nCV = Mrows / 64;
            unsigned* qctr = (unsigned*)ws + 3600 + 64 * l;
            for (;;) {
                __syncthreads();
                if (tid == 0) MISC[4] = atomicAdd(qctr, 1u);
                __syncthreads();
                const int it = (int)MISC[4];
                if (it >= nNA + nG1 + nCV) break;
                if (it < nNA) {
                    if (it < 768) na_item(lds, P, p.rpb + (size_t)l * 6 * 465, BR, it / 384, (it >> 6) % 6, it & 63, 0, tid, wave, lane);
                    else { const int j = it - 768; na_item(lds, P, p.rpb, BR, j / 12, (j >> 1) % 6, -1, j & 1, tid, wave, lane); }
                } else if (it < nNA + nG1) { const int j = it - nNA; gla1_item(lds, p, l, j / (6 * NCH), (j / NCH) % 6, j % NCH, tid, wave, lane); }
                else { conv_item(P, p.conv_w + l * 1536, BR, it - nNA - nG1, tid); }
            }
        }
        GSYNC();

        { PH gla_scan((bf16*)(ws + WS_UBUF), (const float*)(ws + WS_DBUF), bx * 512 + tid, G * 512); }
        GSYNC();

        for (int rep = 0; rep < REP_X3; ++rep) { PH
            const int per = need_ctx ? NCH : 128, nG3 = 12 * per;
            for (int it = bx; it < nG3; it += G) { const int bh = it / per, ci = (it % per) + (need_ctx ? 0 : 4); gla3_item(lds, p, l, bh / 6, bh % 6, ci, tid, wave, lane); }
        }
        GSYNC();

        { PH pg8::Gemm g{BR, (const bf16*)(ws + WS_WM), ML, DM, DM}; pg8::LatentOrder S; S.init(G, bx);
          pg8::EpiMerge E{P, NBUF};
          pg8::gemm_phase<pg8::EpiMerge, pg8::LatentOrder, true, true>(lds, g, S, E); }
        if (l == 0) { PH pg8::Gemm g{BR + (size_t)ML * DM, (const bf16*)(ws + WS_WM), MC, DM, DM}; pg8::StaticOrder S; S.init(MC, DM, G, bx);
          pg8::EpiMerge E{P + (size_t)ML * PS, NBUF + (size_t)ML * DM};
          pg8::gemm_phase<pg8::EpiMerge, pg8::StaticOrder, true, true>(lds, g, S, E); }
        GSYNC();

        { PH pg8::Gemm g{NBUF, (const bf16*)(ws + WS_WO), ML, DM, DM}; pg8::LatentOrder S; S.init(G, bx);
          pg8::EpiResid E{hL, p.out, hC, hc, mv + 2 * DM};
          pg8::gemm_phase<pg8::EpiResid, pg8::LatentOrder, true, true>(lds, g, S, E); }
        if (l == 0) { PH pg8::Gemm g{NBUF + (size_t)ML * DM, (const bf16*)(ws + WS_WO), MC, DM, DM, 512}; pg8::SplitKOrder<4, 512> S; S.init(G, bx);
          pg8::EpiPartial E{PART, mv + 2 * ADA + 2 * DM, 512};
          pg8::gemm_phase<pg8::EpiPartial, pg8::SplitKOrder<4, 512>, true, true>(lds, g, S, E); }
        GSYNC();

        for (int rep = 0; rep < REP_N; ++rep) { PH norm_rows(p.out, hC, p.g_ffn + l * DM, mv, 4, 3, NBUF, Mrows, gw, NGW, lane, PART, need_ctx ? 4 : 0, hc); }
        GSYNC();

        for (int rep = 0; rep < REP_F1; ++rep) { PH pg8::Gemm g{NBUF, (const bf16*)(ws + WS_W13), Mrows, 2 * FF, DM}; pg8::StaticOrder S; S.init(Mrows, 2 * FF, G, bx);
          pg8::EpiSwiglu E{P};
          pg8::gemm_phase<pg8::EpiSwiglu, pg8::StaticOrder, true, true>(lds, g, S, E); }
        GSYNC();

        { PH pg8::Gemm g{P, (const bf16*)(ws + WS_W2), ML, DM, FF}; pg8::LatentOrder S; S.init(G, bx);
          pg8::EpiResid E{p.out, p.out, hc, hc, mv + 5 * DM};
          pg8::gemm_phase<pg8::EpiResid, pg8::LatentOrder, true, true>(lds, g, S, E); }
        if (l == 0) { PH pg8::Gemm g{P + (size_t)ML * FF, (const bf16*)(ws + WS_W2), MC, DM, FF, 512}; pg8::SplitKOrder<11, 512> S; S.init(G, bx);
          pg8::EpiPartial E{PART, mv + 2 * ADA + 5 * DM, 512};
          pg8::gemm_phase<pg8::EpiPartial, pg8::SplitKOrder<11, 512>, true, true>(lds, g, S, E); }
        GSYNC();
    }
    { const int l = 1; PH final_norm(p.out, p.g_final, gw, NGW, lane); }
#endif
}

extern "C" void kernel_launch(void* const* d_in, const int* in_sizes, int n_in, void* d_out, int out_size, void* d_ws, size_t ws_size, hipStream_t stream) {
    static int grid = 0;
    if (grid == 0) {
        if (n_in != 24 || out_size != ML * DM || ws_size < WS_END) { fprintf(stderr, "kernel_launch: unexpected shapes (n_in %d out %d ws %zu)\n", n_in, out_size, ws_size); grid = -1; return; }
        int dev = 0, cus = 0, per_cu = 0;
        hipGetDevice(&dev);
        hipDeviceGetAttribute(&cus, hipDeviceAttributeMultiprocessorCount, dev);
        hipFuncSetAttribute((const void*)mega_fwd, hipFuncAttributeMaxDynamicSharedMemorySize, LDS_BYTES);
        if (hipOccupancyMaxActiveBlocksPerMultiprocessor(&per_cu, (const void*)mega_fwd, 512, LDS_BYTES) != hipSuccess || per_cu < 1) { fprintf(stderr, "kernel_launch: occupancy query gave %d\n", per_cu); per_cu = 1; }
        (void)hipGetLastError();
        grid = cus * 1;
    }
    if (grid < 0) return;
    if (hipMemsetAsync(d_ws, 0, 262144, stream) != hipSuccess) { fprintf(stderr, "memset failed\n"); return; }
    Params p{};
    const float** pp = (const float**)&p;
    for (int i = 0; i < 24; ++i) pp[i] = (const float*)d_in[i];
    p.out = (float*)d_out; p.ws = (unsigned char*)d_ws;
    void* args[] = {&p};
    hipError_t e = hipLaunchCooperativeKernel((const void*)mega_fwd, dim3(grid), dim3(512), args, LDS_BYTES, stream);
    if (e != hipSuccess) fprintf(stderr, "cooperative launch failed: %s (grid %d)\n", hipGetErrorString(e), grid);
}
```
